# Optimizing an MI355X kernel written in HIP

```python
import jax, jax.numpy as jnp
from jax import lax
import numpy as np

D_MODEL = 1024
BATCH = 8
SEQ = 2048
DEPTH = 1
DEC_BATCH = 128
DEC_SEQ = 4
PAST_LEN = 16384
PAGE_SIZE = 128

N_META = 16
D_CONV = D_MODEL
CONV_A_WIDTH = 3
HEAD_K = 128
HEAD_V = 128
N_HEADS = D_MODEL // 128
QKV_DIM = 2 * N_HEADS * HEAD_K + N_HEADS * HEAD_V
CONV_QKV_WIDTH = 4
CHUNK = 64
EPS = 1e-6
IN_SIZES = (D_CONV, D_CONV, D_CONV, D_CONV, QKV_DIM, N_HEADS * HEAD_V, N_HEADS, N_HEADS, D_MODEL, D_MODEL)
N_IN = 4 * D_CONV + QKV_DIM + N_HEADS * HEAD_V + 2 * N_HEADS + 2 * D_MODEL

kernel_name = "hybrid_shortconv_gated_deltanet_step"


def _rmsnorm(x, w):
    xf = x.astype(jnp.float32)
    y = xf * lax.rsqrt(jnp.mean(xf * xf, axis=-1, keepdims=True) + EPS)
    return (y * w.astype(jnp.float32)).astype(x.dtype)


def _l2norm(x):
    return x * lax.rsqrt(jnp.sum(x * x, axis=-1, keepdims=True) + EPS)


def _causal_dwconv(x, prefix, w):
    width = w.shape[0]
    t_len = x.shape[1]
    xp = jnp.concatenate([prefix.astype(x.dtype), x], axis=1)
    y = xp[:, 0:t_len] * w[0]
    for j in range(1, width):
        y = y + xp[:, j:j + t_len] * w[j]
    return y, xp[:, t_len:]


def _delta_chunk(q, k, v, beta, g, s):
    L = q.shape[2]
    G = jnp.cumsum(g, axis=-1)
    diff = G[..., :, None] - G[..., None, :]
    incl = jnp.tril(jnp.ones((L, L), dtype=bool))
    strict = jnp.tril(jnp.ones((L, L), dtype=bool), -1)
    decay = jnp.exp(jnp.where(incl, diff, -jnp.inf))
    kb = k * beta[..., None]
    a = jnp.where(strict, jnp.einsum('bhid,bhjd->bhij', kb, k) * decay, 0.0)
    eye = jnp.eye(L, dtype=q.dtype)
    t_inv = lax.linalg.triangular_solve(eye + a, jnp.broadcast_to(eye, a.shape),
                                        left_side=True, lower=True, unit_diagonal=True)
    value = jnp.einsum('bhij,bhjv->bhiv', t_inv, v * beta[..., None])
    k_cum = jnp.einsum('bhij,bhjd->bhid', t_inv, kb * jnp.exp(G)[..., None])
    v_new = value - jnp.einsum('bhld,bhdv->bhlv', k_cum, s)
    attn = jnp.einsum('bhid,bhjd->bhij', q, k) * decay
    o = (jnp.einsum('bhld,bhdv->bhlv', q * jnp.exp(G)[..., None], s)
         + jnp.einsum('bhij,bhjv->bhiv', attn, v_new))
    g_last = G[..., -1]
    s_new = (s * jnp.exp(g_last)[..., None, None]
             + jnp.einsum('bhld,bhlv->bhdv', k * jnp.exp(g_last[..., None] - G)[..., None], v_new))
    return o, s_new


def _delta_sequence(q, k, v, beta, g, s):
    t_len = q.shape[2]
    n_full = t_len // CHUNK
    rem = t_len - n_full * CHUNK
    outs = []
    if n_full > 0:
        def to_chunks(a):
            a = a[:, :, :n_full * CHUNK]
            a = a.reshape(a.shape[:2] + (n_full, CHUNK) + a.shape[3:])
            return jnp.moveaxis(a, 2, 0)
        xs = tuple(to_chunks(a) for a in (q, k, v, beta, g))

        def step(carry, c):
            o_c, carry = _delta_chunk(c[0], c[1], c[2], c[3], c[4], carry)
            return carry, o_c
        s, o_all = lax.scan(step, s, xs)
        o_all = jnp.moveaxis(o_all, 0, 2)
        outs.append(o_all.reshape(o_all.shape[:2] + (n_full * CHUNK, o_all.shape[-1])))
    if rem > 0:
        st = n_full * CHUNK
        o_r, s = _delta_chunk(q[:, :, st:], k[:, :, st:], v[:, :, st:], beta[:, :, st:], g[:, :, st:], s)
        outs.append(o_r)
    o = outs[0] if len(outs) == 1 else jnp.concatenate(outs, axis=2)
    return o, s


def _layer(x, conv_a_prev, conv_qkv_prev, s_prev, n_meta, norm_pre, norm_post, w_in, b_gate,
           conv_a_w, conv_qkv_w, a_log, dt_bias, gnorm_w, w_a_out, w_b_out, w_o):
    f32 = jnp.float32
    bsz, t_len, _ = x.shape
    xn = _rmsnorm(x, norm_pre)
    proj = xn @ w_in
    splits = []
    acc = 0
    for sz in IN_SIZES[:-1]:
        acc += sz
        splits.append(acc)
    h_a, b_a, c_a, z_a, qkv, z_b, beta_l, alpha_l, gate_a, gate_b = jnp.split(proj, splits, axis=-1)

    conv_u, conv_a_new = _causal_dwconv(c_a * h_a, conv_a_prev, conv_a_w)
    y_a = b_a * conv_u * jax.nn.silu(z_a)

    qkv_c, conv_qkv_new = _causal_dwconv(qkv, conv_qkv_prev, conv_qkv_w)
    qkv_c = jax.nn.silu(qkv_c).astype(f32)
    nk = N_HEADS * HEAD_K

    def heads(a, d):
        return a.reshape(bsz, t_len, N_HEADS, d).transpose(0, 2, 1, 3)
    q = _l2norm(heads(qkv_c[..., :nk], HEAD_K)) * (HEAD_K ** -0.5)
    k = _l2norm(heads(qkv_c[..., nk:2 * nk], HEAD_K))
    v = heads(qkv_c[..., 2 * nk:], HEAD_V)
    beta = jax.nn.sigmoid(beta_l.astype(f32)).transpose(0, 2, 1)
    g = (-jnp.exp(a_log.astype(f32))
         * jax.nn.softplus(alpha_l.astype(f32) + dt_bias.astype(f32))).transpose(0, 2, 1)
    if n_meta > 0:
        o_m, s_mid = _delta_sequence(q[:, :, :n_meta], k[:, :, :n_meta], v[:, :, :n_meta],
                                     beta[:, :, :n_meta], g[:, :, :n_meta], s_prev)
        o_r, s_new = _delta_sequence(q[:, :, n_meta:], k[:, :, n_meta:], v[:, :, n_meta:],
                                     beta[:, :, n_meta:], g[:, :, n_meta:], s_mid)
        o = jnp.concatenate([o_m, o_r], axis=2)
    else:
        o, s_new = _delta_sequence(q, k, v, beta, g, s_prev)
    o = o.transpose(0, 2, 1, 3).astype(x.dtype)
    o = _rmsnorm(o, gnorm_w) * jax.nn.silu(z_b.reshape(bsz, t_len, N_HEADS, HEAD_V))
    y_b = o.reshape(bsz, t_len, N_HEADS * HEAD_V)

    merged = (jax.nn.sigmoid(gate_a + b_gate[:D_MODEL]) * (y_a @ w_a_out)
              + jax.nn.sigmoid(gate_b + b_gate[D_MODEL:]) * (y_b @ w_b_out))
    x = x + _rmsnorm(merged @ w_o, norm_post)
    return x, conv_a_new, conv_qkv_new, s_new.astype(x.dtype)


def setup_inputs(seed: int = 0) -> dict:
    key = jax.random.key(seed)
    ks = jax.random.split(key, 18)
    f32 = jnp.float32

    def nrm(k, shape, scale):
        return jax.random.normal(k, shape, f32) * scale
    x_prompt = nrm(ks[0], (BATCH, SEQ, D_MODEL), 1.0)
    x_sample = nrm(ks[1], (DEC_BATCH, DEC_SEQ, D_MODEL), 1.0)
    state_conv_a = nrm(ks[2], (DEPTH, DEC_BATCH, CONV_A_WIDTH - 1, D_CONV), 1.0)
    state_conv_qkv = nrm(ks[3], (DEPTH, DEC_BATCH, CONV_QKV_WIDTH - 1, QKV_DIM), 1.0)
    state_delta = nrm(ks[4], (DEPTH, DEC_BATCH, N_HEADS, HEAD_K, HEAD_V), HEAD_K ** -0.5)
    meta = nrm(ks[5], (N_META, D_MODEL), 1.0)
    norm_pre = 1.0 + nrm(ks[6], (DEPTH, D_MODEL), 0.02)
    norm_post = 1.0 + nrm(ks[7], (DEPTH, D_MODEL), 0.02)
    w_in = nrm(ks[8], (DEPTH, D_MODEL, N_IN), D_MODEL ** -0.5)
    b_gate = nrm(ks[9], (DEPTH, 2 * D_MODEL), 0.01)
    conv_a_w = nrm(ks[10], (DEPTH, CONV_A_WIDTH, D_CONV), CONV_A_WIDTH ** -0.5)
    conv_qkv_w = nrm(ks[11], (DEPTH, CONV_QKV_WIDTH, QKV_DIM), CONV_QKV_WIDTH ** -0.5)
    a_log = jnp.log(jax.random.uniform(ks[12], (DEPTH, N_HEADS), f32, 1.0, 16.0))
    dt = jax.random.uniform(ks[13], (DEPTH, N_HEADS), f32, 1e-3, 1e-1)
    dt_bias = jnp.log(jnp.expm1(dt))
    gnorm_w = 1.0 + nrm(ks[14], (DEPTH, HEAD_V), 0.02)
    w_a_out = nrm(ks[15], (DEPTH, D_CONV, D_MODEL), D_CONV ** -0.5)
    w_b_out = nrm(ks[16], (DEPTH, N_HEADS * HEAD_V, D_MODEL), (N_HEADS * HEAD_V) ** -0.5)
    w_o = nrm(ks[17], (DEPTH, D_MODEL, D_MODEL), D_MODEL ** -0.5)
    return {"x_prompt": x_prompt, "x_sample": x_sample,
            "state_conv_a": state_conv_a, "state_conv_qkv": state_conv_qkv, "state_delta": state_delta,
            "meta": meta, "norm_pre": norm_pre, "norm_post": norm_post, "w_in": w_in, "b_gate": b_gate,
            "conv_a_w": conv_a_w, "conv_qkv_w": conv_qkv_w, "a_log": a_log, "dt_bias": dt_bias,
            "gnorm_w": gnorm_w, "w_a_out": w_a_out, "w_b_out": w_b_out, "w_o": w_o}


def reference(x_prompt, x_sample, state_conv_a, state_conv_qkv, state_delta, meta, norm_pre, norm_post,
              w_in, b_gate, conv_a_w, conv_qkv_w, a_log, dt_bias, gnorm_w, w_a_out, w_b_out, w_o):
    dtype = x_prompt.dtype
    bsz = x_prompt.shape[0]
    xp = jnp.concatenate([jnp.broadcast_to(meta[None].astype(dtype), (bsz, N_META, D_MODEL)), x_prompt], axis=1)
    xs = x_sample
    ca_p, cq_p, sd_p, ca_s, cq_s, sd_s = [], [], [], [], [], []
    for l in range(DEPTH):
        w = (norm_pre[l], norm_post[l], w_in[l], b_gate[l], conv_a_w[l], conv_qkv_w[l],
             a_log[l], dt_bias[l], gnorm_w[l], w_a_out[l], w_b_out[l], w_o[l])
        zero_a = jnp.zeros((bsz, CONV_A_WIDTH - 1, D_CONV), dtype)
        zero_q = jnp.zeros((bsz, CONV_QKV_WIDTH - 1, QKV_DIM), dtype)
        zero_s = jnp.zeros((bsz, N_HEADS, HEAD_K, HEAD_V), jnp.float32)
        xp, ca, cq, sd = _layer(xp, zero_a, zero_q, zero_s, N_META, *w)
        ca_p.append(ca)
        cq_p.append(cq)
        sd_p.append(sd)
        xs, ca, cq, sd = _layer(xs, state_conv_a[l], state_conv_qkv[l],
                                state_delta[l].astype(jnp.float32), 0, *w)
        ca_s.append(ca)
        cq_s.append(cq)
        sd_s.append(sd)
    y_prompt = xp[:, N_META:]
    return (y_prompt, xs, jnp.stack(ca_p), jnp.stack(cq_p), jnp.stack(sd_p),
            jnp.stack(ca_s), jnp.stack(cq_s), jnp.stack(sd_s))
```

```cpp
#define REC_MASK 31
#include <hip/hip_runtime.h>
#include <hip/hip_cooperative_groups.h>
#include <cstdio>
namespace cg = cooperative_groups;


namespace pg8 {
#define PG8_LAS __attribute__((address_space(3)))
typedef unsigned short bf16_t;
typedef short bf16x8 __attribute__((ext_vector_type(8)));
typedef float f32x4 __attribute__((ext_vector_type(4)));
typedef unsigned u32x4 __attribute__((ext_vector_type(4)));
constexpr int BM = 256, BK = 64, HALF = 128, HTB = HALF * BK * 2  , STAGE_BYTES = 8 * HTB, NXCD = 8, WGM = 8;

__host__ __device__ __forceinline__ int lds_byte(int r, int c) { const int st = (r >> 4) * 2 + (c >> 5), rr = r & 15, cc = c & 31, ob = rr * 64 + cc * 2; return st * 1024 + (ob ^ (((ob >> 9) & 1) << 5)); }
__host__ __device__ __forceinline__ void stage_rc(int b, int& R, int& C) { const int st = b / 1024, sb = b % 1024, swz = sb ^ (((sb >> 9) & 1) << 5); R = (st >> 1) * 16 + swz / 64; C = (st & 1) * 32 + (swz % 64) / 2; }
__host__ __device__ __forceinline__ int perm32(int rho) { const int n = rho >> 4, i = rho & 15; return 8 * (i >> 2) + 4 * n + (i & 3); }


struct Unit { int pm, pn; };
struct Gemm { const bf16_t* A; const bf16_t* Bt; int M, N, K; };

struct StaticOrder {
    int nM, nN, nwg, G, c;
    __host__ __device__ void init(int M, int N, int G_, int c_) { nM = M / BM; nN = N / BM; nwg = nM * nN; G = G_; c = c_; }
    __host__ __device__ bool next(int i, Unit& u) const {
        const long L = (long)i * G + c; if (L >= nwg) return false;
        int wgid = (int)L; { const int q = nwg / NXCD, r = nwg % NXCD, xcd = wgid % NXCD, off = wgid / NXCD; wgid = (xcd < r ? xcd * (q + 1) : r * (q + 1) + (xcd - r) * q) + off; }
        const int nig = WGM * nN, gid = wgid / nig, fm = gid * WGM, gsz = (nM - fm) < WGM ? (nM - fm) : WGM;
        u.pm = fm + ((wgid % nig) % gsz); u.pn = (wgid % nig) / gsz; return true;
    }
    __device__ __forceinline__ void a_ready(const Unit&) const {}
    __device__ __forceinline__ void done(const Unit&) const {}
};

__device__ __forceinline__ unsigned cvt_pk_bf16(float lo, float hi) { unsigned r; asm volatile("v_cvt_pk_bf16_f32 %0, %1, %2" : "=v"(r) : "v"(lo), "v"(hi)); return r; }

template <class Epi, class Sched, bool STAMP = false>
__device__ __forceinline__ void gemm_phase(PG8_LAS unsigned char* lds, const Gemm g, const Sched& S, const Epi& E, unsigned long long* stamps) {
    const int tid = threadIdx.x, wid = __builtin_amdgcn_readfirstlane(tid >> 6), lane = tid & 63, wr = wid >> 2, wc = wid & 3, fr = lane & 15, fq = lane >> 4;
    const int K = g.K, nt = K / BK;
    int ts_lo = 0, ts_hi = 0, nts = 0; const unsigned long long rt_entry = STAMP ? (unsigned long long)wall_clock64() : 0ull;
#define PG8_STAMP() do { if (STAMP && wid == 0 && nts < 64) { const unsigned long long _c = (unsigned long long)clock64(); \
        ts_lo = (lane == nts) ? (int)(unsigned)_c : ts_lo; ts_hi = (lane == nts) ? (int)(unsigned)(_c >> 32) : ts_hi; ++nts; } } while (0)
    PG8_STAMP();
    unsigned voffA[2], voffB[2];
#pragma unroll
    for (int i = 0; i < 2; ++i) { int R, C; stage_rc(tid * 16 + i * 8192, R, C); const int Rb = Epi::PERM ? ((R & ~31) + perm32(R & 31)) : R;
        voffA[i] = (unsigned)(R * K + C) * 2u; voffB[i] = (unsigned)(Rb * K + C) * 2u; }
    const size_t kstep = (size_t)(BK * 2);
    const size_t hstep = (size_t)HALF * K * 2;
    const size_t tstep = 2 * hstep;
    const unsigned ldsw = (unsigned)wid * 1024u;
    const int aoff = lds_byte(wr * 64 + fr, fq * 8), boff = lds_byte(wc * 32 + fr, fq * 8);
#define PG8_SA(b, h) (((b) * 2 + (h)) * HTB)
#define PG8_SB(b, h) ((4 + (b) * 2 + (h)) * HTB)
#define PG8_STAGE(bufoff, gbase, voff) do { _Pragma("unroll") for (int _i = 0; _i < 2; ++_i) \
        __builtin_amdgcn_global_load_lds((const unsigned*)((const char*)(gbase) + (voff)[_i]), (PG8_LAS unsigned*)(lds + (bufoff) + ldsw + _i * 8192), 16, 0, 0); } while (0)
#define PG8_LDA(dst, b, h) do { _Pragma("unroll") for (int m = 0; m < 4; ++m) _Pragma("unroll") for (int k = 0; k < 2; ++k) dst[m][k] = *(const PG8_LAS bf16x8*)(lds + PG8_SA(b, h) + aoff + m * 2048 + k * 1024); } while (0)
#define PG8_LDB(dst, b, h) do { _Pragma("unroll") for (int n = 0; n < 2; ++n) _Pragma("unroll") for (int k = 0; k < 2; ++k) dst[n][k] = *(const PG8_LAS bf16x8*)(lds + PG8_SB(b, h) + boff + n * 2048 + k * 1024); } while (0)
#define PG8_MMA(ai, bj, At, Bt) do { __builtin_amdgcn_s_setprio(1); _Pragma("unroll") for (int m = 0; m < 4; ++m) _Pragma("unroll") for (int n = 0; n < 2; ++n) _Pragma("unroll") for (int k = 0; k < 2; ++k) \
        acc[ai][bj][m][n] = __builtin_amdgcn_mfma_f32_16x16x32_bf16(Bt[n][k], At[m][k], acc[ai][bj][m][n], 0, 0, 0); __builtin_amdgcn_s_setprio(0); } while (0)
#define PG8_WAIT_V(n) asm volatile("s_waitcnt vmcnt(" #n ")" ::: "memory")
#define PG8_WAIT_L(n) asm volatile("s_waitcnt lgkmcnt(" #n ")" ::: "memory")
#define PG8_BAR __builtin_amdgcn_s_barrier()
#define PG8_SCHED __builtin_amdgcn_sched_barrier(0)
    Unit cur, nxt; int ui = 0;
    if (!S.next(0, cur)) return;
    f32x4 acc[2][2][4][2];
#pragma unroll
    for (int a = 0; a < 2; ++a)
#pragma unroll
        for (int b = 0; b < 2; ++b)
#pragma unroll
            for (int m = 0; m < 4; ++m)
#pragma unroll
                for (int n = 0; n < 2; ++n) acc[a][b][m][n] = (f32x4){0.f, 0.f, 0.f, 0.f};
    bf16x8 At[4][2], B0[2][2], B1[2][2];
    const char* cA = (const char*)g.A + (size_t)cur.pm * tstep; const char* cB = (const char*)g.Bt + (size_t)cur.pn * tstep;
    S.a_ready(cur);
    PG8_STAGE(PG8_SB(0, 0), cB, voffB); PG8_STAGE(PG8_SA(0, 0), cA, voffA); PG8_STAGE(PG8_SB(0, 1), cB + hstep, voffB); PG8_STAGE(PG8_SA(0, 1), cA + hstep, voffA);
    if (wr == 1) PG8_BAR;
    PG8_WAIT_V(4); PG8_BAR;
    PG8_STAGE(PG8_SB(1, 0), cB + kstep, voffB); PG8_STAGE(PG8_SA(1, 0), cA + kstep, voffA); PG8_STAGE(PG8_SB(1, 1), cB + hstep + kstep, voffB);
    PG8_WAIT_V(6); PG8_BAR;
    PG8_STAMP();
    for (;;) {
        const bool has_next = S.next(ui + 1, nxt);
        const char* nA = has_next ? (const char*)g.A + (size_t)nxt.pm * tstep : cA; const char* nB = has_next ? (const char*)g.Bt + (size_t)nxt.pn * tstep : cB;
        for (int t = 0; t < nt; t += 2) {
            const bool last = (t == nt - 2);
            const char* a1 = cA + (size_t)(t + 1) * kstep;
            const char* a2 = last ? nA : cA + (size_t)(t + 2) * kstep; const char* b2 = last ? nB : cB + (size_t)(t + 2) * kstep;
            const char* a3 = a2 + kstep; const char* b3 = b2 + kstep;
            if (last && has_next) S.a_ready(nxt);
            if constexpr (Epi::HAS_MID) { if (t == (nt >> 1)) E.mid(acc, cur, wr, wc, fr, fq); }
            PG8_LDB(B0, 0, 0); PG8_SCHED; PG8_LDA(At, 0, 0); PG8_STAGE(PG8_SA(1, 1), a1 + hstep, voffA);
            PG8_WAIT_L(8); PG8_BAR; PG8_WAIT_L(0); PG8_MMA(0, 0, At, B0); PG8_BAR; PG8_SCHED;
            PG8_LDB(B1, 0, 1); PG8_STAGE(PG8_SB(0, 0), b2, voffB);
            PG8_BAR; PG8_WAIT_L(0); PG8_MMA(0, 1, At, B1); PG8_BAR;
            PG8_LDA(At, 0, 1); PG8_STAGE(PG8_SA(0, 0), a2, voffA);
            PG8_BAR; PG8_WAIT_L(0); PG8_MMA(1, 0, At, B0); PG8_BAR; PG8_SCHED;
            PG8_STAGE(PG8_SB(0, 1), b2 + hstep, voffB);
            PG8_WAIT_V(6); PG8_BAR; PG8_MMA(1, 1, At, B1); PG8_BAR;
            PG8_LDB(B0, 1, 0); PG8_SCHED; PG8_LDA(At, 1, 0); PG8_STAGE(PG8_SA(0, 1), a2 + hstep, voffA);
            PG8_WAIT_L(8); PG8_BAR; PG8_WAIT_L(0); PG8_MMA(0, 0, At, B0); PG8_BAR; PG8_SCHED;
            PG8_LDB(B1, 1, 1); PG8_STAGE(PG8_SB(1, 0), b3, voffB);
            PG8_BAR; PG8_WAIT_L(0); PG8_MMA(0, 1, At, B1); PG8_BAR;
            PG8_LDA(At, 1, 1); PG8_STAGE(PG8_SA(1, 0), a3, voffA);
            PG8_BAR; PG8_WAIT_L(0); PG8_MMA(1, 0, At, B0); PG8_BAR; PG8_SCHED;
            PG8_STAGE(PG8_SB(1, 1), b3 + hstep, voffB);
            PG8_WAIT_V(6); PG8_BAR; PG8_MMA(1, 1, At, B1); PG8_BAR;
        }
        PG8_STAMP();
        if constexpr (!Epi::AFTER_DRAIN) { E(acc, cur, wr, wc, fr, fq); S.done(cur); }
        PG8_STAMP();
        if (!has_next) break;
#pragma unroll
        for (int a = 0; a < 2; ++a)
#pragma unroll
            for (int b = 0; b < 2; ++b)
#pragma unroll
                for (int m = 0; m < 4; ++m)
#pragma unroll
                    for (int n = 0; n < 2; ++n) acc[a][b][m][n] = (f32x4){0.f, 0.f, 0.f, 0.f};
        cur = nxt; cA = nA; cB = nB; ++ui;
    }
    PG8_WAIT_V(0);
    if (wr == 0) PG8_BAR;
    PG8_BAR;
    if constexpr (Epi::AFTER_DRAIN) { E.fused(acc, cur, wr, wc, fr, fq, lds, wid, lane); S.done(cur); }
    PG8_STAMP();
    if (STAMP && wid == 0) { stamps[lane] = lane < nts ? (((unsigned long long)(unsigned)ts_hi << 32) | (unsigned)ts_lo) : 0ull;
        if (lane == 62) stamps[62] = rt_entry; if (lane == 63) stamps[63] = (unsigned long long)wall_clock64(); }
#undef PG8_STAMP
#undef PG8_SA
#undef PG8_SB
#undef PG8_STAGE
#undef PG8_LDA
#undef PG8_LDB
#undef PG8_MMA
#undef PG8_WAIT_V
#undef PG8_WAIT_L
#undef PG8_BAR
#undef PG8_SCHED
}
}


using pg8::bf16_t; using pg8::bf16x8; using pg8::f32x4; using pg8::Unit; using pg8::Gemm; using pg8::StaticOrder;

constexpr int DM = 1024, NB = 8, SEQ = 2048, NMETA = 16, TP = SEQ + NMETA, DB = 128, DS = 4, NH = 8;
constexpr int MPROWS = NB * TP;
constexpr int MREAL = MPROWS + DB * DS;
constexpr int MPAD = 17152;
constexpr int NIN = 10256, QKVD = 3072;
constexpr int NCPS = 33, NCHUNK = NB * NH * NCPS;
constexpr float EPSF = 1e-6f;
constexpr size_t O_YP = 0, O_YS = 16777216, O_CAP = 17301504, O_CQP = 17317888, O_DP = 17391616, O_CAS = 18440192, O_CQS = 18702336, O_DSM = 19881984;
constexpr size_t WS_WTA = 0, WS_WTB = 2097152, WS_WTO = 4194304, WS_BETA = 6291456, WS_G = 6840320, WS_SSQ = 7389184, WS_EG = 11780096, WS_OS = 11788544, WS_BAR = 12845056,
                 WS_XN = 13631488, WS_WTIN = 48758784, WS_QKV = 69730304, WS_YA = WS_QKV, WS_YB = WS_QKV + 35127296, WS_MERGED = WS_QKV + 70254592,
                 WS_CHA = 175112192, WS_UB = WS_CHA, WS_BZ = WS_CHA + 35127296, WS_GA = WS_CHA, WS_GB = WS_CHA + 35127296;
constexpr int CH_REC = 73728, CH_IN_WS = 1265;
constexpr int LDS_BYTES = 139264;

struct P {
    const float *x_prompt, *x_sample, *st_conv_a, *st_conv_qkv, *st_delta, *meta, *norm_pre, *norm_post, *w_in, *b_gate,
                *conv_a_w, *conv_qkv_w, *a_log, *dt_bias, *gnorm_w, *w_a_out, *w_b_out, *w_o;
    float* out; unsigned char* ws;
};

__device__ __forceinline__ float bf2f(unsigned b) { return __uint_as_float(b << 16); }
typedef float f32x2_t __attribute__((ext_vector_type(2)));
typedef __bf16 bf16x2_t __attribute__((ext_vector_type(2)));
__device__ __forceinline__ unsigned pk2(float lo, float hi) { const f32x2_t v = {lo, hi}; const bf16x2_t b = __builtin_convertvector(v, bf16x2_t); return __builtin_bit_cast(unsigned, b); }
__device__ __forceinline__ float sigm(float x) { return 1.f / (1.f + __expf(-x)); }
__device__ __forceinline__ float silu(float x) { return x / (1.f + __expf(-x)); }
__device__ __forceinline__ f32x4 mfma16(bf16x8 a, bf16x8 b, f32x4 c) { return __builtin_amdgcn_mfma_f32_16x16x32_bf16(a, b, c, 0, 0, 0); }
__device__ __forceinline__ void unpack8(uint4 v, float* f) {
    f[0] = bf2f(v.x & 0xffffu); f[1] = bf2f(v.x >> 16); f[2] = bf2f(v.y & 0xffffu); f[3] = bf2f(v.y >> 16);
    f[4] = bf2f(v.z & 0xffffu); f[5] = bf2f(v.z >> 16); f[6] = bf2f(v.w & 0xffffu); f[7] = bf2f(v.w >> 16);
}
__device__ __forceinline__ unsigned char* chunk_rec(const P& p, int ci) {
    return ci < CH_IN_WS ? p.ws + WS_CHA + (size_t)ci * CH_REC : (unsigned char*)p.out + (size_t)(ci - CH_IN_WS) * CH_REC;
}

__device__ __forceinline__ int wtin_col(int c) {
    if (c < 4096) { const int g = c & ~31, w = c & 31, n = (w >> 4) & 1, fq = (w >> 2) & 3, j = w & 3; return 4096 + g + 8 * fq + 4 * n + j; }
    if (c < 8192) { const int rel = c - 4096, pn = rel >> 8, w = rel & 255, bj = w >> 7, wc = (w >> 5) & 3, n = (w >> 4) & 1, i = w & 15;
        const int type = bj * 2 + n, ch = 64 * pn + 16 * wc + i; const int off = type == 0 ? 0 : (type == 1 ? 2048 : (type == 2 ? 1024 : 3072)); return off + ch; }
    const int rel = c - 8192, pn = rel >> 8, w = rel & 255, bj = w >> 7, wc = (w >> 5) & 3, n = (w >> 4) & 1, i = w & 15;
    return 8208 + n * 1024 + 128 * pn + 64 * bj + 16 * wc + i;
}

__device__ __forceinline__ void phase0(const P& p, unsigned char* smem) {
    const int tid = threadIdx.x, lane = tid & 63, wid = tid >> 6;
    float* tileS = (float*)smem;
    for (int tile = blockIdx.x; tile < 2560 + 512 + 256; tile += gridDim.x) {
        const float* src; int ld, n0, k0, srow0, mode; bf16_t* dst; int Kd;
        if (tile < 2560) { mode = 0; n0 = (tile >> 4) * 64; k0 = (tile & 15) * 64; src = p.w_in; ld = NIN; srow0 = k0; dst = (bf16_t*)(p.ws + WS_WTIN); Kd = 1024; }
        else if (tile < 3072) { const int t = (tile - 2560) & 255; mode = 1; n0 = (t >> 4) * 64; k0 = (t & 15) * 64; src = (tile < 2816) ? p.w_a_out : p.w_b_out; ld = 1024; srow0 = k0; dst = (bf16_t*)(p.ws + ((tile < 2816) ? WS_WTA : WS_WTB)); Kd = 1024; }
        else { const int t = tile - 3072; mode = 1; n0 = (t >> 4) * 64; k0 = (t & 15) * 64; src = p.w_o; ld = 1024; srow0 = k0; dst = (bf16_t*)(p.ws + WS_WTO); Kd = 1024; }
        {
            const int nn = tid & 63; const int col = mode == 0 ? wtin_col(n0 + nn) : (n0 + nn);
#pragma unroll
            for (int i = 0; i < 8; ++i) { const int kk = (tid >> 6) + 8 * i; tileS[kk * 65 + nn] = src[(size_t)(srow0 + kk) * ld + col]; }
        }
        __syncthreads();
        {
            const int nn = tid >> 3, kq = tid & 7; float f[8];
#pragma unroll
            for (int j = 0; j < 8; ++j) f[j] = tileS[(kq * 8 + j) * 65 + nn];
            uint4 o; o.x = pk2(f[0], f[1]); o.y = pk2(f[2], f[3]); o.z = pk2(f[4], f[5]); o.w = pk2(f[6], f[7]);
            *(uint4*)(dst + (size_t)(n0 + nn) * Kd + k0 + kq * 8) = o;
        }
        __syncthreads();
    }
    float* wsl = (float*)smem;
    for (int idx = tid; idx < 4096; idx += 512) { const int k = idx >> 2, q = idx & 3; const float4 v = *(const float4*)(p.w_in + (size_t)k * NIN + 8192 + q * 4);
        wsl[(q * 4 + 0) * 1024 + k] = v.x; wsl[(q * 4 + 1) * 1024 + k] = v.y; wsl[(q * 4 + 2) * 1024 + k] = v.z; wsl[(q * 4 + 3) * 1024 + k] = v.w; }
    __syncthreads();
    bf16_t* xn = (bf16_t*)(p.ws + WS_XN);
    float* betab = (float*)(p.ws + WS_BETA); float* gb = (float*)(p.ws + WS_G);
    for (int r = blockIdx.x * 8 + wid; r < MPAD; r += gridDim.x * 8) {
        if (r >= MREAL) {
#pragma unroll
            for (int i = 0; i < 4; ++i) *(uint2*)(xn + (size_t)r * 1024 + i * 256 + lane * 4) = make_uint2(0u, 0u);
            continue;
        }
        const float* src;
        if (r < MPROWS) { const int b = r / TP, t = r - b * TP; src = (t < NMETA) ? p.meta + (size_t)t * DM : p.x_prompt + ((size_t)b * SEQ + (t - NMETA)) * DM; }
        else src = p.x_sample + (size_t)(r - MPROWS) * DM;
        float x[16]; float ssq = 0.f;
#pragma unroll
        for (int i = 0; i < 4; ++i) { const float4 v = *(const float4*)(src + i * 256 + lane * 4); x[i * 4 + 0] = v.x; x[i * 4 + 1] = v.y; x[i * 4 + 2] = v.z; x[i * 4 + 3] = v.w;
            ssq += v.x * v.x + v.y * v.y + v.z * v.z + v.w * v.w; }
#pragma unroll
        for (int m = 32; m >= 1; m >>= 1) ssq += __shfl_xor(ssq, m);
        const float rs = rsqrtf(ssq * (1.f / 1024.f) + EPSF);
#pragma unroll
        for (int i = 0; i < 4; ++i) { const float4 w = *(const float4*)(p.norm_pre + i * 256 + lane * 4);
            x[i * 4 + 0] *= rs * w.x; x[i * 4 + 1] *= rs * w.y; x[i * 4 + 2] *= rs * w.z; x[i * 4 + 3] *= rs * w.w;
            *(uint2*)(xn + (size_t)r * 1024 + i * 256 + lane * 4) = make_uint2(pk2(x[i * 4 + 0], x[i * 4 + 1]), pk2(x[i * 4 + 2], x[i * 4 + 3])); }
        float a[16];
#pragma unroll
        for (int j = 0; j < 16; ++j) { float s = 0.f;
#pragma unroll
            for (int i = 0; i < 4; ++i) { const float4 w = *(const float4*)(wsl + j * 1024 + i * 256 + lane * 4);
                s += x[i * 4 + 0] * w.x + x[i * 4 + 1] * w.y + x[i * 4 + 2] * w.z + x[i * 4 + 3] * w.w; }
            a[j] = s; }
#pragma unroll
        for (int i = 0; i < 8; ++i) { const bool up = lane & 32; const float keep = up ? a[i + 8] : a[i], send = up ? a[i] : a[i + 8]; a[i] = keep + __shfl_xor(send, 32); }
#pragma unroll
        for (int i = 0; i < 4; ++i) { const bool up = lane & 16; const float keep = up ? a[i + 4] : a[i], send = up ? a[i] : a[i + 4]; a[i] = keep + __shfl_xor(send, 16); }
#pragma unroll
        for (int i = 0; i < 2; ++i) { const bool up = lane & 8; const float keep = up ? a[i + 2] : a[i], send = up ? a[i] : a[i + 2]; a[i] = keep + __shfl_xor(send, 8); }
        { const bool up = lane & 4; const float keep = up ? a[1] : a[0], send = up ? a[0] : a[1]; a[0] = keep + __shfl_xor(send, 4); }
        a[0] += __shfl_xor(a[0], 2); a[0] += __shfl_xor(a[0], 1);
        if ((lane & 3) == 0) {
            const int j = ((lane >> 5) & 1) * 8 + ((lane >> 4) & 1) * 4 + ((lane >> 3) & 1) * 2 + ((lane >> 2) & 1);
            if (j < 8) betab[(size_t)r * 8 + j] = sigm(a[0]);
            else { const int h = j - 8; const float z = a[0] + p.dt_bias[h]; const float sp = z > 20.f ? z : log1pf(__expf(z)); gb[(size_t)r * 8 + h] = -__expf(p.a_log[h]) * sp; }
        }
    }
}

struct EpiIn {
    static constexpr bool PERM = false, AFTER_DRAIN = false, HAS_MID = false;
    int mode; P p;
    __device__ __forceinline__ void operator()(const f32x4 (&acc)[2][2][4][2], const Unit& u, int wr, int wc, int fr, int fq) const {
        const int row0 = u.pm * 256 + wr * 64 + fr;
        if (mode == 0) {
            bf16_t* qkv = (bf16_t*)(p.ws + WS_QKV);
#pragma unroll
            for (int ai = 0; ai < 2; ++ai)
#pragma unroll
                for (int m = 0; m < 4; ++m) { const int row = row0 + ai * 128 + m * 16; if (row < MREAL) {
#pragma unroll
                    for (int bj = 0; bj < 2; ++bj) { const int oc = u.pn * 256 + bj * 128 + wc * 32 + 8 * fq; const f32x4 v0 = acc[ai][bj][m][0], v1 = acc[ai][bj][m][1];
                        uint4 o; o.x = pk2(v0[0], v0[1]); o.y = pk2(v0[2], v0[3]); o.z = pk2(v1[0], v1[1]); o.w = pk2(v1[2], v1[3]);
                        *(uint4*)(qkv + (size_t)row * QKVD + oc) = o; } } }
        } else if (mode == 1) {
            if (u.pn < 4) {
                bf16_t* Y = (bf16_t*)(p.ws + WS_YB); const float* ssq = (const float*)(p.ws + WS_SSQ);
#pragma unroll
                for (int bj = 0; bj < 2; ++bj) { const int oc = u.pn * 256 + bj * 128 + wc * 32 + 8 * fq; const int head = oc >> 7;
                    const float4 g0 = *(const float4*)(p.gnorm_w + (oc & 127)), g1 = *(const float4*)(p.gnorm_w + (oc & 127) + 4);
#pragma unroll
                    for (int ai = 0; ai < 2; ++ai)
#pragma unroll
                        for (int m = 0; m < 4; ++m) { const int row = row0 + ai * 128 + m * 16; if (row < MREAL) {
                            const float4 s0 = *(const float4*)(ssq + (size_t)row * 64 + head * 8), s1 = *(const float4*)(ssq + (size_t)row * 64 + head * 8 + 4);
                            const float rstd = rsqrtf((s0.x + s0.y + s0.z + s0.w + s1.x + s1.y + s1.z + s1.w) * (1.f / 128.f) + EPSF);
                            bf16_t* yp = Y + (size_t)row * 1024 + oc; float o[8]; unpack8(*(const uint4*)yp, o);
                            const f32x4 v0 = acc[ai][bj][m][0], v1 = acc[ai][bj][m][1];
                            uint4 r; r.x = pk2(o[0] * rstd * g0.x * silu(v0[0]), o[1] * rstd * g0.y * silu(v0[1])); r.y = pk2(o[2] * rstd * g0.z * silu(v0[2]), o[3] * rstd * g0.w * silu(v0[3]));
                            r.z = pk2(o[4] * rstd * g1.x * silu(v1[0]), o[5] * rstd * g1.y * silu(v1[1])); r.w = pk2(o[6] * rstd * g1.z * silu(v1[2]), o[7] * rstd * g1.w * silu(v1[3]));
                            *(uint4*)yp = r; } } }
            } else {
                bf16_t* ub = (bf16_t*)(p.ws + WS_UB); bf16_t* bz = (bf16_t*)(p.ws + WS_BZ);
                const int ch = 64 * (u.pn - 4) + 16 * wc + 4 * fq;
#pragma unroll
                for (int ai = 0; ai < 2; ++ai)
#pragma unroll
                    for (int m = 0; m < 4; ++m) { const int row = row0 + ai * 128 + m * 16; if (row < MREAL) {
                        const f32x4 h = acc[ai][0][m][0], c = acc[ai][0][m][1], b = acc[ai][1][m][0], z = acc[ai][1][m][1];
                        *(uint2*)(ub + (size_t)row * 1024 + ch) = make_uint2(pk2(h[0] * c[0], h[1] * c[1]), pk2(h[2] * c[2], h[3] * c[3]));
                        *(uint2*)(bz + (size_t)row * 1024 + ch) = make_uint2(pk2(b[0] * silu(z[0]), b[1] * silu(z[1])), pk2(b[2] * silu(z[2]), b[3] * silu(z[3]))); } }
            }
        } else {
            bf16_t* R = (bf16_t*)(p.ws + WS_GA); bf16_t* GB = (bf16_t*)(p.ws + WS_GB);
#pragma unroll
            for (int bj = 0; bj < 2; ++bj) { const int ch = 128 * u.pn + 64 * bj + 16 * wc + 4 * fq;
                const float4 ba = *(const float4*)(p.b_gate + ch), bb = *(const float4*)(p.b_gate + 1024 + ch);
#pragma unroll
                for (int ai = 0; ai < 2; ++ai)
#pragma unroll
                    for (int m = 0; m < 4; ++m) { const int row = row0 + ai * 128 + m * 16; if (row < MREAL) {
                        const f32x4 a = acc[ai][bj][m][0], b = acc[ai][bj][m][1];
                        const float ga0 = sigm(a[0] + ba.x), ga1 = sigm(a[1] + ba.y), ga2 = sigm(a[2] + ba.z), ga3 = sigm(a[3] + ba.w);
                        const float gb0 = sigm(b[0] + bb.x), gb1 = sigm(b[1] + bb.y), gb2 = sigm(b[2] + bb.z), gb3 = sigm(b[3] + bb.w);
                        *(uint2*)(R + (size_t)row * 1024 + ch) = make_uint2(pk2(ga0, ga1), pk2(ga2, ga3));
                        *(uint2*)(GB + (size_t)row * 1024 + ch) = make_uint2(pk2(gb0, gb1), pk2(gb2, gb3)); } } }
        }
    }
};

struct EpiMerge {
    static constexpr bool PERM = false, AFTER_DRAIN = false, HAS_MID = false;
    int pass; P p;
    __device__ __forceinline__ void operator()(const f32x4 (&acc)[2][2][4][2], const Unit& u, int wr, int wc, int fr, int fq) const {
        const bf16_t* G = (const bf16_t*)(p.ws + (pass ? WS_GB : WS_GA)); bf16_t* Mg = (bf16_t*)(p.ws + WS_MERGED);
        const int row0 = u.pm * 256 + wr * 64 + fr, col0 = u.pn * 256 + wc * 32 + 4 * fq;
#pragma unroll
        for (int ai = 0; ai < 2; ++ai)
#pragma unroll
            for (int m = 0; m < 4; ++m)
#pragma unroll
                for (int bj = 0; bj < 2; ++bj)
#pragma unroll
                    for (int n = 0; n < 2; ++n) { const size_t off = (size_t)(row0 + ai * 128 + m * 16) * 1024 + col0 + bj * 128 + n * 16; const uint2 v = *(const uint2*)(G + off);
                        const f32x4 a = acc[ai][bj][m][n];
                        float r0 = a[0] * bf2f(v.x & 0xffffu), r1 = a[1] * bf2f(v.x >> 16), r2 = a[2] * bf2f(v.y & 0xffffu), r3 = a[3] * bf2f(v.y >> 16);
                        if (pass) { const uint2 o = *(const uint2*)(Mg + off); r0 += bf2f(o.x & 0xffffu); r1 += bf2f(o.x >> 16); r2 += bf2f(o.y & 0xffffu); r3 += bf2f(o.y >> 16); }
                        *(uint2*)(Mg + off) = make_uint2(pk2(r0, r1), pk2(r2, r3)); }
    }
};

struct EpiPre {
    static constexpr bool PERM = false, AFTER_DRAIN = false, HAS_MID = false;
    P p;
    __device__ __forceinline__ void operator()(const f32x4 (&acc)[2][2][4][2], const Unit& u, int wr, int wc, int fr, int fq) const {
        const int row0 = u.pm * 256 + wr * 64 + fr, col0 = u.pn * 256 + wc * 32 + 4 * fq;
#pragma unroll
        for (int ai = 0; ai < 2; ++ai)
#pragma unroll
            for (int m = 0; m < 4; ++m) { const int row = row0 + ai * 128 + m * 16; float* dst = nullptr;
                if (row < MPROWS) { const int b = row / TP, t = row - b * TP; if (t >= NMETA) dst = p.out + O_YP + ((size_t)b * SEQ + (t - NMETA)) * DM; }
                else if (row < MREAL) dst = p.out + O_YS + (size_t)(row - MPROWS) * DM;
                if (dst) {
#pragma unroll
                    for (int bj = 0; bj < 2; ++bj)
#pragma unroll
                        for (int n = 0; n < 2; ++n) *(f32x4*)(dst + col0 + bj * 128 + n * 16) = acc[ai][bj][m][n]; } }
    }
};


template <int N> __device__ __forceinline__ void tri_merge(const float* Am, float* Tm, float* M1, int tid) {
    constexpr int TOT = (32 / N) * N * N;
    for (int o = tid; o < TOT; o += 512) { const int pr = o / (N * N), i = (o / N) % N, j = o % N, base = pr * 2 * N; float s = 0.f;
#pragma unroll 8
        for (int k = 0; k < N; ++k) s += Am[(base + N + i) * 68 + base + k] * Tm[(base + k) * 68 + base + j];
        M1[(pr * N + i) * 36 + j] = s; }
    __syncthreads();
    for (int o = tid; o < TOT; o += 512) { const int pr = o / (N * N), i = (o / N) % N, j = o % N, base = pr * 2 * N; float s = 0.f;
#pragma unroll 8
        for (int k = 0; k < N; ++k) s += Tm[(base + N + i) * 68 + base + N + k] * M1[(pr * N + k) * 36 + j];
        Tm[(base + N + i) * 68 + base + j] = -s; }
    __syncthreads();
}

__device__ __forceinline__ void phase2(const P& p, unsigned char* smem) {
    const int tid = threadIdx.x, lane = tid & 63, wid = tid >> 6, fr = lane & 15, fq = lane >> 4;
    float* Gs = (float*)smem; float* Bs = (float*)(smem + 256);
    bf16_t* kS = (bf16_t*)(smem + 512); bf16_t* qS = kS + 64 * 136; bf16_t* vbT = qS + 64 * 136; bf16_t* kbgT = vbT + 128 * 72; bf16_t* kdT = kbgT + 128 * 72;
    float* Am = (float*)(kdT + 128 * 72); float* Tm = Am + 64 * 68; float* M1 = Tm + 64 * 68; bf16_t* Tb = (bf16_t*)(M1 + 32 * 36);
    const bf16_t* qkv = (const bf16_t*)(p.ws + WS_QKV);
    const float* betab = (const float*)(p.ws + WS_BETA); const float* gbuf = (const float*)(p.ws + WS_G);
    float* egb = (float*)(p.ws + WS_EG);
#ifndef P2_PARTS
#define P2_PARTS 3
#endif
    for (int ci = blockIdx.x; ci < ((P2_PARTS & 1) ? NCHUNK : 0); ci += gridDim.x) {
        const int bh = ci / NCPS, c = ci - bh * NCPS, b = bh >> 3, h = bh & 7;
        const int t0 = c == 0 ? 0 : NMETA + 64 * (c - 1), L = c == 0 ? NMETA : 64;
        const int rb = b * TP + t0;
        unsigned char* rec = chunk_rec(p, ci);
        if (tid < 64) {
            float gv = (tid < L) ? gbuf[(size_t)(rb + tid) * 8 + h] : 0.f; const float bv = (tid < L) ? betab[(size_t)(rb + tid) * 8 + h] : 0.f;
#pragma unroll
            for (int d = 1; d < 64; d <<= 1) { const float o = __shfl_up(gv, d); if (lane >= d) gv += o; }
            Gs[tid] = gv; Bs[tid] = bv;
        }
        for (int i = tid; i < 64 * 68; i += 512) Tm[i] = 0.f;
        __syncthreads();
        {
            const int t = tid >> 3, ch0 = (tid & 7) * 16;
            const float Gt = Gs[t], Gl = Gs[63], bt = Bs[t]; const float eG = __expf(Gt), eD = __expf(Gl - Gt); const bool valid = t < L;
#pragma unroll
            for (int s = 0; s < 3; ++s) {
                float y[16];
#pragma unroll
                for (int e = 0; e < 16; ++e) y[e] = 0.f;
                const int col0 = s * 1024 + h * 128 + ch0;
#pragma unroll
                for (int j = 0; j < 4; ++j) { const int tt = t0 + t - 3 + j;
                    if (valid && tt >= 0) { const bf16_t* xr = qkv + (size_t)(b * TP + tt) * QKVD + col0; float xv[16]; unpack8(*(const uint4*)xr, xv); unpack8(*(const uint4*)(xr + 8), xv + 8);
                        const float* wr_ = p.conv_qkv_w + j * QKVD + col0;
#pragma unroll
                        for (int q = 0; q < 4; ++q) { const float4 w = *(const float4*)(wr_ + q * 4); y[q * 4 + 0] += w.x * xv[q * 4 + 0]; y[q * 4 + 1] += w.y * xv[q * 4 + 1]; y[q * 4 + 2] += w.z * xv[q * 4 + 2]; y[q * 4 + 3] += w.w * xv[q * 4 + 3]; } } }
                float ssq = 0.f;
#pragma unroll
                for (int e = 0; e < 16; ++e) { y[e] = valid ? silu(y[e]) : 0.f; ssq += y[e] * y[e]; }
                if (s < 2) { ssq += __shfl_xor(ssq, 1); ssq += __shfl_xor(ssq, 2); ssq += __shfl_xor(ssq, 4); }
                if (s == 0) { const float rn = rsqrtf(ssq + EPSF) * 0.08838834764831845f;
#pragma unroll
                    for (int e = 0; e < 16; ++e) y[e] *= rn;
                    uint4 a, bq; a.x = pk2(y[0], y[1]); a.y = pk2(y[2], y[3]); a.z = pk2(y[4], y[5]); a.w = pk2(y[6], y[7]); bq.x = pk2(y[8], y[9]); bq.y = pk2(y[10], y[11]); bq.z = pk2(y[12], y[13]); bq.w = pk2(y[14], y[15]);
                    *(uint4*)(qS + t * 136 + ch0) = a; *(uint4*)(qS + t * 136 + ch0 + 8) = bq;
                    uint4 c0, c1; c0.x = pk2(y[0] * eG, y[1] * eG); c0.y = pk2(y[2] * eG, y[3] * eG); c0.z = pk2(y[4] * eG, y[5] * eG); c0.w = pk2(y[6] * eG, y[7] * eG);
                    c1.x = pk2(y[8] * eG, y[9] * eG); c1.y = pk2(y[10] * eG, y[11] * eG); c1.z = pk2(y[12] * eG, y[13] * eG); c1.w = pk2(y[14] * eG, y[15] * eG);
                    bf16_t* qg = (bf16_t*)(rec + 16384) + t * 128 + ch0; if (REC_MASK & 1) { *(uint4*)qg = c0; *(uint4*)(qg + 8) = c1; }
                } else if (s == 1) { const float rn = rsqrtf(ssq + EPSF);
#pragma unroll
                    for (int e = 0; e < 16; ++e) y[e] *= rn;
                    uint4 a, bq; a.x = pk2(y[0], y[1]); a.y = pk2(y[2], y[3]); a.z = pk2(y[4], y[5]); a.w = pk2(y[6], y[7]); bq.x = pk2(y[8], y[9]); bq.y = pk2(y[10], y[11]); bq.z = pk2(y[12], y[13]); bq.w = pk2(y[14], y[15]);
                    *(uint4*)(kS + t * 136 + ch0) = a; *(uint4*)(kS + t * 136 + ch0 + 8) = bq;
                    const float f1 = bt * eG;
#pragma unroll
                    for (int e = 0; e < 16; ++e) { kbgT[(ch0 + e) * 72 + t] = (bf16_t)(pk2(y[e] * f1, 0.f) & 0xffffu); kdT[(ch0 + e) * 72 + t] = (bf16_t)(pk2(y[e] * eD, 0.f) & 0xffffu); }
                } else {
#pragma unroll
                    for (int e = 0; e < 16; ++e) vbT[(ch0 + e) * 72 + t] = (bf16_t)(pk2(y[e] * bt, 0.f) & 0xffffu);
                }
            }
        }
        __syncthreads();
        {
#pragma unroll
            for (int i = 0; i < 2; ++i) { const int idx = tid * 2 + i, kch = idx >> 3, pc = idx & 7; if (REC_MASK & 2) *(uint4*)(rec + 32768 + (kch * 64 + pc * 8) * 2) = *(const uint4*)(kdT + kch * 72 + pc * 8); }
            if (tid == 0) egb[ci] = __expf(Gs[63]);
        }
        {
            const int mt = wid & 3, sel = wid >> 2; const bf16_t* As = sel ? qS : kS;
            bf16x8 af[4];
#pragma unroll
            for (int kk = 0; kk < 4; ++kk) af[kk] = *(const bf16x8*)(As + (16 * mt + fr) * 136 + 32 * kk + 8 * fq);
#pragma unroll
            for (int nt = 0; nt < 4; ++nt) {
                f32x4 acc = {0.f, 0.f, 0.f, 0.f};
                if (nt <= mt) {
#pragma unroll
                    for (int kk = 0; kk < 4; ++kk) { const bf16x8 bb = *(const bf16x8*)(kS + (16 * nt + fr) * 136 + 32 * kk + 8 * fq); acc = mfma16(af[kk], bb, acc); }
                }
                const int j = 16 * nt + fr; const float Gj = Gs[j];
#pragma unroll
                for (int jj = 0; jj < 4; ++jj) { const int i = 16 * mt + 4 * fq + jj; const float dec = (i >= j) ? __expf(Gs[i] - Gj) : 0.f;
                    if (sel == 0) Am[i * 68 + j] = (i > j) ? Bs[i] * acc[jj] * dec : 0.f;
                    else if (REC_MASK & 4) ((bf16_t*)(rec + 65536))[i * 64 + j] = (bf16_t)(pk2(acc[jj] * dec, 0.f) & 0xffffu); }
            }
        }
        __syncthreads();
        if (wid == 0) {
            const int blk = lane >> 4, cc = lane & 15; float x[16];
#pragma unroll
            for (int i = 0; i < 16; ++i) { float s = (i == cc) ? 1.f : 0.f;
#pragma unroll
                for (int j = 0; j < i; ++j) s -= Am[(16 * blk + i) * 68 + 16 * blk + j] * x[j];
                x[i] = s; }
#pragma unroll
            for (int i = 0; i < 16; ++i) Tm[(16 * blk + i) * 68 + 16 * blk + cc] = x[i];
        }
        __syncthreads();
        tri_merge<16>(Am, Tm, M1, tid);
        tri_merge<32>(Am, Tm, M1, tid);
        { const int row = tid >> 3, c8 = (tid & 7) * 8; const float4 a = *(const float4*)(Tm + row * 68 + c8), bq = *(const float4*)(Tm + row * 68 + c8 + 4);
            uint4 o; o.x = pk2(a.x, a.y); o.y = pk2(a.z, a.w); o.z = pk2(bq.x, bq.y); o.w = pk2(bq.z, bq.w); *(uint4*)(Tb + row * 72 + c8) = o; }
        __syncthreads();
        if (REC_MASK & 32) { for (int i = tid; i < 64 * 72 / 8; i += 512) *(uint4*)(rec + 49152 + i * 16) = *(const uint4*)(Tb + i * 8); }
        if (REC_MASK & 64) { for (int i = tid; i < 1024; i += 512) *(uint4*)(rec + i * 16) = *(const uint4*)(vbT + i * 8); }
        if (REC_MASK & 128) { for (int i = tid; i < 1024; i += 512) *(uint4*)(rec + i * 16) = *(const uint4*)((const unsigned char*)Am + i * 16); }
        if (wid < 4) {
            const int mt = wid; bf16x8 af[2];
#pragma unroll
            for (int kk = 0; kk < 2; ++kk) af[kk] = *(const bf16x8*)(Tb + (16 * mt + fr) * 72 + 32 * kk + 8 * fq);
#pragma unroll
            for (int nt = 0; nt < 8; ++nt) { f32x4 acc = {0.f, 0.f, 0.f, 0.f};
#pragma unroll
                for (int kk = 0; kk < 2; ++kk) { const bf16x8 bb = *(const bf16x8*)(vbT + (16 * nt + fr) * 72 + 32 * kk + 8 * fq); acc = mfma16(af[kk], bb, acc); }
                if (REC_MASK & 8) *(uint2*)(rec + 49152 + ((16 * nt + fr) * 64 + 16 * mt + 4 * fq) * 2) = make_uint2(pk2(acc[0], acc[1]), pk2(acc[2], acc[3])); }
        } else {
#pragma unroll
            for (int mi = 0; mi < 2; ++mi) { const int mt = (wid - 4) * 2 + mi; bf16x8 af[2];
#pragma unroll
                for (int kk = 0; kk < 2; ++kk) af[kk] = *(const bf16x8*)(kbgT + (16 * mt + fr) * 72 + 32 * kk + 8 * fq);
#pragma unroll
                for (int nt = 0; nt < 4; ++nt) { f32x4 acc = {0.f, 0.f, 0.f, 0.f};
#pragma unroll
                    for (int kk = 0; kk < 2; ++kk) { const bf16x8 bb = *(const bf16x8*)(Tb + (16 * nt + fr) * 72 + 32 * kk + 8 * fq); acc = mfma16(af[kk], bb, acc); }
                    if (REC_MASK & 16) *(uint2*)(rec + ((16 * nt + fr) * 128 + 16 * mt + 4 * fq) * 2) = make_uint2(pk2(acc[0], acc[1]), pk2(acc[2], acc[3])); } }
        }
        __syncthreads();
    }
    {
        float* qs = (float*)smem; float* ks = qs + 512; float* vs = ks + 512; float* red = vs + 512; float* red2 = red + 512; float* nrm = red2 + 512;
        bf16_t* osb = (bf16_t*)(p.ws + WS_OS); float* ssq8 = (float*)(p.ws + WS_SSQ);
        for (int unit = blockIdx.x; unit < ((P2_PARTS & 2) ? DB * NH : 0); unit += gridDim.x) {
            const int b = unit >> 3, h = unit & 7; const int t = tid >> 7, ch = tid & 127;
            float yv[3];
#pragma unroll
            for (int s = 0; s < 3; ++s) { const int col = s * 1024 + h * 128 + ch; float y = 0.f;
#pragma unroll
                for (int j = 0; j < 4; ++j) { const int tt = t - 3 + j;
                    const float xin = tt < 0 ? p.st_conv_qkv[((size_t)b * 3 + (tt + 3)) * QKVD + col] : bf2f(qkv[(size_t)(MPROWS + b * 4 + tt) * QKVD + col]);
                    y += p.conv_qkv_w[j * QKVD + col] * xin; }
                yv[s] = silu(y); }
#pragma unroll
            for (int s = 0; s < 2; ++s) { float q = yv[s] * yv[s];
#pragma unroll
                for (int m = 32; m >= 1; m >>= 1) q += __shfl_xor(q, m);
                if (lane == 0) nrm[(s * 4 + t) * 2 + (wid & 1)] = q; }
            __syncthreads();
            { const float nq = nrm[(0 * 4 + t) * 2] + nrm[(0 * 4 + t) * 2 + 1], nk = nrm[(1 * 4 + t) * 2] + nrm[(1 * 4 + t) * 2 + 1];
              qs[t * 128 + ch] = yv[0] * rsqrtf(nq + EPSF) * 0.08838834764831845f; ks[t * 128 + ch] = yv[1] * rsqrtf(nk + EPSF); vs[t * 128 + ch] = yv[2]; }
            __syncthreads();
            const int v = tid & 127, kq = tid >> 7; float s[32];
            const float* sd = p.st_delta + ((size_t)(b * 8 + h) * 128 + kq * 32) * 128 + v;
#pragma unroll
            for (int i = 0; i < 32; ++i) s[i] = sd[(size_t)i * 128];
#pragma unroll 1
            for (int tk = 0; tk < 4; ++tk) {
                const int row = MPROWS + b * 4 + tk;
                const float eg = __expf(gbuf[(size_t)row * 8 + h]), bt = betab[(size_t)row * 8 + h];
                float pa = 0.f;
#pragma unroll
                for (int i = 0; i < 32; ++i) pa += ks[tk * 128 + kq * 32 + i] * s[i];
                red[kq * 128 + v] = pa;
                __syncthreads();
                const float kv = eg * (red[v] + red[128 + v] + red[256 + v] + red[384 + v]);
                const float vn = bt * (vs[tk * 128 + v] - kv);
                float po = 0.f;
#pragma unroll
                for (int i = 0; i < 32; ++i) { s[i] = eg * s[i] + ks[tk * 128 + kq * 32 + i] * vn; po += qs[tk * 128 + kq * 32 + i] * s[i]; }
                red2[kq * 128 + v] = po;
                __syncthreads();
                if (tid < 128) { const float o = red2[v] + red2[128 + v] + red2[256 + v] + red2[384 + v];
                    osb[(size_t)(row - MPROWS) * 1024 + h * 128 + v] = (bf16_t)(pk2(o, 0.f) & 0xffffu);
                    float q = o * o;
#pragma unroll
                    for (int m = 32; m >= 1; m >>= 1) q += __shfl_xor(q, m);
                    if (lane == 0) ssq8[(size_t)row * 64 + h * 8 + wid] = q;
                } else if (tid < 134) ssq8[(size_t)row * 64 + h * 8 + 2 + (tid - 128)] = 0.f;
            }
            float* so = p.out + O_DSM + ((size_t)(b * 8 + h) * 128 + kq * 32) * 128 + v;
#pragma unroll
            for (int i = 0; i < 32; ++i) so[(size_t)i * 128] = s[i];
            __syncthreads();
        }
    }
    for (int idx = blockIdx.x * 512 + tid; idx < (NB + DB) * 3 * (QKVD / 8); idx += gridDim.x * 512) {
        const int c8 = idx % (QKVD / 8), rr = (idx / (QKVD / 8)) % 3, bb = idx / (3 * (QKVD / 8));
        const bf16_t* src; float* dst;
        if (bb < NB) { src = qkv + (size_t)(bb * TP + TP - 3 + rr) * QKVD + c8 * 8; dst = p.out + O_CQP + ((size_t)bb * 3 + rr) * QKVD + c8 * 8; }
        else { const int b2 = bb - NB; src = qkv + (size_t)(MPROWS + b2 * 4 + 1 + rr) * QKVD + c8 * 8; dst = p.out + O_CQS + ((size_t)b2 * 3 + rr) * QKVD + c8 * 8; }
        float f[8]; unpack8(*(const uint4*)src, f);
        *(float4*)dst = make_float4(f[0], f[1], f[2], f[3]); *(float4*)(dst + 4) = make_float4(f[4], f[5], f[6], f[7]);
    }
}

struct ScanOps { bf16x8 aw[4], aq[4], aat[2], akd[2][2]; uint2 uu; float eg; };
__device__ __forceinline__ void scan_load(ScanOps& o, const P& p, int ci, int mt, int nt, int kt0, int vs, int fr, int fq) {
    const unsigned char* rec = chunk_rec(p, ci);
#pragma unroll
    for (int kk = 0; kk < 4; ++kk) { o.aw[kk] = *(const bf16x8*)(rec + ((16 * mt + fr) * 128 + 32 * kk + 8 * fq) * 2); o.aq[kk] = *(const bf16x8*)(rec + 16384 + ((16 * mt + fr) * 128 + 32 * kk + 8 * fq) * 2); }
#pragma unroll
    for (int kk = 0; kk < 2; ++kk) { o.aat[kk] = *(const bf16x8*)(rec + 65536 + ((16 * mt + fr) * 64 + 32 * kk + 8 * fq) * 2);
#pragma unroll
        for (int i = 0; i < 2; ++i) o.akd[i][kk] = *(const bf16x8*)(rec + 32768 + ((16 * (kt0 + i) + fr) * 64 + 32 * kk + 8 * fq) * 2); }
    o.uu = *(const uint2*)(rec + 49152 + ((vs * 32 + 16 * nt + fr) * 64 + 16 * mt + 4 * fq) * 2);
    o.eg = ((const float*)(p.ws + WS_EG))[ci];
}

__device__ __forceinline__ void phase3(const P& p, unsigned char* smem) {
    const int tid = threadIdx.x, lane = tid & 63, wid = tid >> 6, fr = lane & 15, fq = lane >> 4;
    bf16_t* sT = (bf16_t*)smem;
    bf16_t* vnT = sT + 32 * 136;
    bf16_t* Y = (bf16_t*)(p.ws + WS_YB); float* ssq8 = (float*)(p.ws + WS_SSQ);
    const int mt = wid & 3, nt = wid >> 2, kt0 = (wid & 3) * 2;
    for (int idx = blockIdx.x * 512 + tid; idx < DB * DS * 128; idx += gridDim.x * 512) { const int r = idx >> 7, c8 = (idx & 127) * 8;
        *(uint4*)(Y + (size_t)(MPROWS + r) * 1024 + c8) = *(const uint4*)((const bf16_t*)(p.ws + WS_OS) + (size_t)r * 1024 + c8); }
    for (int unit = blockIdx.x; unit < NB * NH * 4; unit += gridDim.x) {
        const int bh = unit >> 2, vs = unit & 3, b = bh >> 3, h = bh & 7;
        for (int i = tid; i < 32 * 136 / 2; i += 512) ((unsigned*)sT)[i] = 0u;
        f32x4 S[2]; S[0] = (f32x4){0.f, 0.f, 0.f, 0.f}; S[1] = S[0];
        ScanOps cur; scan_load(cur, p, bh * NCPS, mt, nt, kt0, vs, fr, fq);
        __syncthreads();
#pragma unroll 1
        for (int c = 0; c < NCPS; ++c) {
            ScanOps nxt; scan_load(nxt, p, bh * NCPS + (c + 1 < NCPS ? c + 1 : c), mt, nt, kt0, vs, fr, fq);
            const int t0 = c == 0 ? 0 : NMETA + 64 * (c - 1), L = c == 0 ? NMETA : 64; const int rb = b * TP + t0;
            f32x4 Pv = {0.f, 0.f, 0.f, 0.f}, Q = {0.f, 0.f, 0.f, 0.f};
#pragma unroll
            for (int kk = 0; kk < 4; ++kk) { const bf16x8 bs = *(const bf16x8*)(sT + (16 * nt + fr) * 136 + 32 * kk + 8 * fq); Pv = mfma16(cur.aw[kk], bs, Pv); Q = mfma16(cur.aq[kk], bs, Q); }
            { const float u0 = bf2f(cur.uu.x & 0xffffu), u1 = bf2f(cur.uu.x >> 16), u2 = bf2f(cur.uu.y & 0xffffu), u3 = bf2f(cur.uu.y >> 16);
              *(uint2*)(vnT + (16 * nt + fr) * 72 + 16 * mt + 4 * fq) = make_uint2(pk2(u0 - Pv[0], u1 - Pv[1]), pk2(u2 - Pv[2], u3 - Pv[3])); }
            __syncthreads();
            bf16x8 bv[2];
#pragma unroll
            for (int kk = 0; kk < 2; ++kk) bv[kk] = *(const bf16x8*)(vnT + (16 * nt + fr) * 72 + 32 * kk + 8 * fq);
#pragma unroll
            for (int kk = 0; kk < 2; ++kk) Q = mfma16(cur.aat[kk], bv[kk], Q);
#pragma unroll
            for (int i = 0; i < 2; ++i) { S[i] *= cur.eg;
#pragma unroll
                for (int kk = 0; kk < 2; ++kk) S[i] = mfma16(cur.akd[i][kk], bv[kk], S[i]);
                *(uint2*)(sT + (16 * nt + fr) * 136 + 16 * (kt0 + i) + 4 * fq) = make_uint2(pk2(S[i][0], S[i][1]), pk2(S[i][2], S[i][3])); }
            {
                float sq[4];
#pragma unroll
                for (int jj = 0; jj < 4; ++jj) { sq[jj] = Q[jj] * Q[jj]; sq[jj] += __shfl_xor(sq[jj], 1); sq[jj] += __shfl_xor(sq[jj], 2); sq[jj] += __shfl_xor(sq[jj], 4); sq[jj] += __shfl_xor(sq[jj], 8); }
#pragma unroll
                for (int jj = 0; jj < 4; ++jj) { const int t = 16 * mt + 4 * fq + jj; if (t < L) {
                    Y[(size_t)(rb + t) * 1024 + h * 128 + vs * 32 + 16 * nt + fr] = (bf16_t)(pk2(Q[jj], 0.f) & 0xffffu);
                    if (fr == 0) ssq8[(size_t)(rb + t) * 64 + h * 8 + vs * 2 + nt] = sq[jj]; } }
            }
            __syncthreads();
            cur = nxt;
        }
        float* dp = p.out + O_DP + (size_t)bh * 16384;
#pragma unroll
        for (int i = 0; i < 2; ++i)
#pragma unroll
            for (int jj = 0; jj < 4; ++jj) dp[(16 * (kt0 + i) + 4 * fq + jj) * 128 + vs * 32 + 16 * nt + fr] = S[i][jj];
        __syncthreads();
    }
}

__device__ __forceinline__ void phase_conva(const P& p) {
    const bf16_t* ub = (const bf16_t*)(p.ws + WS_UB); const bf16_t* bz = (const bf16_t*)(p.ws + WS_BZ); bf16_t* Y = (bf16_t*)(p.ws + WS_YA);
    for (int idx = blockIdx.x * 512 + threadIdx.x; idx < MREAL * 128; idx += gridDim.x * 512) {
        const int row = idx >> 7, ch = (idx & 127) * 8; int b, t; bool samp;
        if (row < MPROWS) { b = row / TP; t = row - b * TP; samp = false; } else { b = (row - MPROWS) >> 2; t = (row - MPROWS) & 3; samp = true; }
        float u0[8], u1[8], u2[8], zz[8];
        unpack8(*(const uint4*)(ub + (size_t)row * 1024 + ch), u2);
#pragma unroll
        for (int d = 1; d <= 2; ++d) { float* dst = d == 1 ? u1 : u0;
            if (t - d >= 0) unpack8(*(const uint4*)(ub + (size_t)(row - d) * 1024 + ch), dst);
            else if (samp) { const float* s = p.st_conv_a + ((size_t)b * 2 + (2 + t - d)) * 1024 + ch; const float4 a = *(const float4*)s, c = *(const float4*)(s + 4);
                dst[0] = a.x; dst[1] = a.y; dst[2] = a.z; dst[3] = a.w; dst[4] = c.x; dst[5] = c.y; dst[6] = c.z; dst[7] = c.w; }
            else {
#pragma unroll
                for (int e = 0; e < 8; ++e) dst[e] = 0.f; } }
        unpack8(*(const uint4*)(bz + (size_t)row * 1024 + ch), zz);
        float y[8];
#pragma unroll
        for (int e = 0; e < 8; ++e) y[e] = zz[e] * (p.conv_a_w[ch + e] * u0[e] + p.conv_a_w[1024 + ch + e] * u1[e] + p.conv_a_w[2048 + ch + e] * u2[e]);
        uint4 o; o.x = pk2(y[0], y[1]); o.y = pk2(y[2], y[3]); o.z = pk2(y[4], y[5]); o.w = pk2(y[6], y[7]);
        *(uint4*)(Y + (size_t)row * 1024 + ch) = o;
        float* cdst = nullptr;
        if (!samp && t >= TP - 2) cdst = p.out + O_CAP + ((size_t)b * 2 + (t - (TP - 2))) * 1024 + ch;
        if (samp && t >= 2) cdst = p.out + O_CAS + ((size_t)b * 2 + (t - 2)) * 1024 + ch;
        if (cdst) { *(float4*)cdst = make_float4(u2[0], u2[1], u2[2], u2[3]); *(float4*)(cdst + 4) = make_float4(u2[4], u2[5], u2[6], u2[7]); }
    }
}

__device__ __forceinline__ void phase_final(const P& p) {
    const int lane = threadIdx.x & 63, wid = threadIdx.x >> 6;
    for (int r = blockIdx.x * 8 + wid; r < NB * SEQ + DB * DS; r += gridDim.x * 8) {
        float* dst; const float* xs;
        if (r < NB * SEQ) { dst = p.out + O_YP + (size_t)r * DM; xs = p.x_prompt + (size_t)r * DM; } else { dst = p.out + O_YS + (size_t)(r - NB * SEQ) * DM; xs = p.x_sample + (size_t)(r - NB * SEQ) * DM; }
        float4 v[4]; float ssq = 0.f;
#pragma unroll
        for (int i = 0; i < 4; ++i) { v[i] = *(const float4*)(dst + i * 256 + lane * 4); ssq += v[i].x * v[i].x + v[i].y * v[i].y + v[i].z * v[i].z + v[i].w * v[i].w; }
#pragma unroll
        for (int m = 32; m >= 1; m >>= 1) ssq += __shfl_xor(ssq, m);
        const float rs = rsqrtf(ssq * (1.f / 1024.f) + EPSF);
#pragma unroll
        for (int i = 0; i < 4; ++i) { const float4 w = *(const float4*)(p.norm_post + i * 256 + lane * 4), x = *(const float4*)(xs + i * 256 + lane * 4);
            *(float4*)(dst + i * 256 + lane * 4) = make_float4(x.x + v[i].x * rs * w.x, x.y + v[i].y * rs * w.y, x.z + v[i].z * rs * w.z, x.w + v[i].w * rs * w.w); }
    }
}

#ifndef PH_MASK
#define PH_MASK 0x3ff
#endif
__device__ __forceinline__ void gbar(unsigned* ctr, unsigned target) {
    __builtin_amdgcn_fence(__ATOMIC_RELEASE, "agent");
    asm volatile("s_waitcnt vmcnt(0) lgkmcnt(0)" ::: "memory");
    __syncthreads();
    if (threadIdx.x == 0) {
        __hip_atomic_fetch_add(ctr, 1u, __ATOMIC_RELEASE, __HIP_MEMORY_SCOPE_AGENT);
        while (__hip_atomic_load(ctr, __ATOMIC_ACQUIRE, __HIP_MEMORY_SCOPE_AGENT) < target) __builtin_amdgcn_s_sleep(2);
    }
    __syncthreads();
    __builtin_amdgcn_fence(__ATOMIC_ACQUIRE, "agent");
    asm volatile("s_waitcnt vmcnt(0)" ::: "memory");
}
__global__ __launch_bounds__(512, 2) void hybrid_fwd(P p) {
    extern __shared__ __attribute__((aligned(16))) unsigned char smem[];
    cg::grid_group grid = cg::this_grid();
    PG8_LAS unsigned char* lds = (PG8_LAS unsigned char*)smem;
    unsigned* bar = (unsigned*)(p.ws + WS_BAR);
    grid.sync();
    const bf16_t* xn = (const bf16_t*)(p.ws + WS_XN); const bf16_t* wtin = (const bf16_t*)(p.ws + WS_WTIN);
#if (PH_MASK >> 0) & 1
    phase0(p, smem);
#endif
    gbar(bar, 1u * gridDim.x);
#if (PH_MASK >> 1) & 1
    { StaticOrder S; S.init(MPAD, 3072, (int)gridDim.x, (int)blockIdx.x); EpiIn E; E.mode = 0; E.p = p; pg8::gemm_phase<EpiIn, StaticOrder, false>(lds, Gemm{xn, wtin, MPAD, 3072, 1024}, S, E, nullptr); }
#endif
    gbar(bar, 2u * gridDim.x);
#if (PH_MASK >> 2) & 1
    phase2(p, smem);
#endif
#ifdef DBG_DUMP
    { const uint4* src = (const uint4*)(p.ws + WS_QKV); uint4* dst = (uint4*)p.out; for (size_t i = (size_t)blockIdx.x * 512 + threadIdx.x; i < (size_t)6000000; i += (size_t)gridDim.x * 512) dst[i] = src[i];
      const uint4* s2 = (const uint4*)(p.ws + WS_BETA); for (size_t i = (size_t)blockIdx.x * 512 + threadIdx.x; i < (size_t)68000; i += (size_t)gridDim.x * 512) dst[6000000 + i] = s2[i]; }
#endif
    gbar(bar, 3u * gridDim.x);
#if (PH_MASK >> 3) & 1
    phase3(p, smem);
#endif
    gbar(bar, 4u * gridDim.x);
#if (PH_MASK >> 4) & 1
    { StaticOrder S; S.init(MPAD, 5120, (int)gridDim.x, (int)blockIdx.x); EpiIn E; E.mode = 1; E.p = p; pg8::gemm_phase<EpiIn, StaticOrder, false>(lds, Gemm{xn, wtin + (size_t)3072 * 1024, MPAD, 5120, 1024}, S, E, nullptr); }
#endif
    gbar(bar, 5u * gridDim.x);
#if (PH_MASK >> 5) & 1
    phase_conva(p);
#endif
    gbar(bar, 6u * gridDim.x);
#if (PH_MASK >> 6) & 1
    { StaticOrder S; S.init(MPAD, 2048, (int)gridDim.x, (int)blockIdx.x); EpiIn E; E.mode = 2; E.p = p; pg8::gemm_phase<EpiIn, StaticOrder, false>(lds, Gemm{xn, wtin + (size_t)8192 * 1024, MPAD, 2048, 1024}, S, E, nullptr); }
#endif
    gbar(bar, 7u * gridDim.x);
#if (PH_MASK >> 7) & 1
    { StaticOrder S; S.init(MPAD, 1024, (int)gridDim.x, (int)blockIdx.x); EpiMerge E; E.p = p; E.pass = 0; pg8::gemm_phase<EpiMerge, StaticOrder, false>(lds, Gemm{(const bf16_t*)(p.ws + WS_YA), (const bf16_t*)(p.ws + WS_WTA), MPAD, 1024, 1024}, S, E, nullptr);
      E.pass = 1; pg8::gemm_phase<EpiMerge, StaticOrder, false>(lds, Gemm{(const bf16_t*)(p.ws + WS_YB), (const bf16_t*)(p.ws + WS_WTB), MPAD, 1024, 1024}, S, E, nullptr); }
#endif
    gbar(bar, 8u * gridDim.x);
#if (PH_MASK >> 8) & 1
    { StaticOrder S; S.init(MPAD, 1024, (int)gridDim.x, (int)blockIdx.x); EpiPre E; E.p = p; pg8::gemm_phase<EpiPre, StaticOrder, false>(lds, Gemm{(const bf16_t*)(p.ws + WS_MERGED), (const bf16_t*)(p.ws + WS_WTO), MPAD, 1024, 1024}, S, E, nullptr); }
#endif
    gbar(bar, 9u * gridDim.x);
#if (PH_MASK >> 9) & 1
    phase_final(p);
#endif
}

extern "C" void kernel_launch(void* const* d_in, const int* in_sizes, int n_in, void* d_out, int out_size, void* d_ws, size_t ws_size, hipStream_t stream) {
    static int grid_blocks = 0;
    if (!grid_blocks) {
        int dev = 0, cus = 0, per_cu = 0;
        hipGetDevice(&dev);
        hipDeviceGetAttribute(&cus, hipDeviceAttributeMultiprocessorCount, dev);
        hipFuncSetAttribute((const void*)hybrid_fwd, hipFuncAttributeMaxDynamicSharedMemorySize, LDS_BYTES);
        hipOccupancyMaxActiveBlocksPerMultiprocessor(&per_cu, (const void*)hybrid_fwd, 512, LDS_BYTES);
        if (per_cu < 1) per_cu = 1;
        grid_blocks = cus * per_cu;
        if (ws_size < (size_t)268435456) fprintf(stderr, "kernel_launch: workspace %zu smaller than the 256 MiB this kernel maps\n", ws_size);
    }
    P p{};
    const float* const* in = (const float* const*)d_in;
    p.x_prompt = in[0]; p.x_sample = in[1]; p.st_conv_a = in[2]; p.st_conv_qkv = in[3]; p.st_delta = in[4]; p.meta = in[5]; p.norm_pre = in[6]; p.norm_post = in[7];
    p.w_in = in[8]; p.b_gate = in[9]; p.conv_a_w = in[10]; p.conv_qkv_w = in[11]; p.a_log = in[12]; p.dt_bias = in[13]; p.gnorm_w = in[14]; p.w_a_out = in[15]; p.w_b_out = in[16]; p.w_o = in[17];
    p.out = (float*)d_out; p.ws = (unsigned char*)d_ws;
    hipMemsetAsync((char*)d_ws + WS_BAR, 0, 256, stream);
    void* args[] = {&p};
    hipError_t e = hipLaunchCooperativeKernel((const void*)hybrid_fwd, dim3(grid_blocks), dim3(512), args, LDS_BYTES, stream);
    if (e != hipSuccess) fprintf(stderr, "cooperative launch failed: %s (grid %d)\n", hipGetErrorString(e), grid_blocks);
}
```

```cpp
#define REC_MASK 31
#ifndef RPT_MASK
#define RPT_MASK 0
#endif
#define RPT_P2 3
#ifndef BLK_RPT
#define BLK_RPT 0
#endif
#include <hip/hip_runtime.h>
#include <hip/hip_cooperative_groups.h>
#include <cstdio>
namespace cg = cooperative_groups;


namespace pg8 {
#define PG8_LAS __attribute__((address_space(3)))
typedef unsigned short bf16_t;
typedef short bf16x8 __attribute__((ext_vector_type(8)));
typedef float f32x4 __attribute__((ext_vector_type(4)));
typedef unsigned u32x4 __attribute__((ext_vector_type(4)));
constexpr int BM = 256, BK = 64, HALF = 128, HTB = HALF * BK * 2  , STAGE_BYTES = 8 * HTB, NXCD = 8, WGM = 4;

__host__ __device__ __forceinline__ int lds_byte(int r, int c) { const int st = (r >> 4) * 2 + (c >> 5), rr = r & 15, cc = c & 31, ob = rr * 64 + cc * 2; return st * 1024 + (ob ^ (((ob >> 9) & 1) << 5)); }
__host__ __device__ __forceinline__ void stage_rc(int b, int& R, int& C) { const int st = b / 1024, sb = b % 1024, swz = sb ^ (((sb >> 9) & 1) << 5); R = (st >> 1) * 16 + swz / 64; C = (st & 1) * 32 + (swz % 64) / 2; }
__host__ __device__ __forceinline__ int perm32(int rho) { const int n = rho >> 4, i = rho & 15; return 8 * (i >> 2) + 4 * n + (i & 3); }


struct Unit { int pm, pn, tag; };
struct Gemm { const bf16_t* A; const bf16_t* Bt; int M, N, K; };

struct StaticOrder {
    int nM, nN, nwg, G, c;
    __host__ __device__ void init(int M, int N, int G_, int c_) { nM = M / BM; nN = N / BM; nwg = nM * nN; G = G_; c = c_; }
    __host__ __device__ bool next(int i, Unit& u) const {
        const long L = (long)i * G + c; if (L >= nwg) return false;
        int wgid = (int)L; { const int q = nwg / NXCD, r = nwg % NXCD, xcd = wgid % NXCD, off = wgid / NXCD; wgid = (xcd < r ? xcd * (q + 1) : r * (q + 1) + (xcd - r) * q) + off; }
        const int nig = WGM * nN, gid = wgid / nig, fm = gid * WGM, gsz = (nM - fm) < WGM ? (nM - fm) : WGM;
        u.pm = fm + ((wgid % nig) % gsz); u.pn = (wgid % nig) / gsz; return true;
    }
    __device__ __forceinline__ void a_ready(const Unit&) const {}
    __device__ __forceinline__ void done(const Unit&) const {}
};

__device__ __forceinline__ unsigned cvt_pk_bf16(float lo, float hi) { unsigned r; asm volatile("v_cvt_pk_bf16_f32 %0, %1, %2" : "=v"(r) : "v"(lo), "v"(hi)); return r; }

template <class Epi, class Sched, bool STAMP = false>
__device__ __forceinline__ void gemm_phase(PG8_LAS unsigned char* lds, const Gemm g, const Sched& S, const Epi& E, unsigned long long* stamps) {
    int tid_ = threadIdx.x; asm volatile("" : "+v"(tid_));
    const int tid = tid_, wid = __builtin_amdgcn_readfirstlane(tid >> 6), lane = tid & 63, wr = wid >> 2, wc = wid & 3, fr = lane & 15, fq = lane >> 4;
    const int K = g.K, nt = K / BK;
    int ts_lo = 0, ts_hi = 0, nts = 0; const unsigned long long rt_entry = STAMP ? (unsigned long long)wall_clock64() : 0ull;
#define PG8_STAMP() do { if (STAMP && wid == 0 && nts < 64) { const unsigned long long _c = (unsigned long long)clock64(); \
        ts_lo = (lane == nts) ? (int)(unsigned)_c : ts_lo; ts_hi = (lane == nts) ? (int)(unsigned)(_c >> 32) : ts_hi; ++nts; } } while (0)
    PG8_STAMP();
    unsigned voffA[2], voffB[2];
#pragma unroll
    for (int i = 0; i < 2; ++i) { int R, C; stage_rc(tid * 16 + i * 8192, R, C); const int Rb = Epi::PERM ? ((R & ~31) + perm32(R & 31)) : R;
        voffA[i] = (unsigned)(R * K + C) * 2u; voffB[i] = (unsigned)(Rb * K + C) * 2u; }
    const size_t kstep = (size_t)(BK * 2);
    const size_t hstep = (size_t)HALF * K * 2;
    const size_t tstep = 2 * hstep;
    const unsigned ldsw = (unsigned)wid * 1024u;
    const int aoff = lds_byte(wr * 64 + fr, fq * 8), boff = lds_byte(wc * 32 + fr, fq * 8);
#define PG8_SA(b, h) (((b) * 2 + (h)) * HTB)
#define PG8_SB(b, h) ((4 + (b) * 2 + (h)) * HTB)
#define PG8_STAGE(bufoff, gbase, voff) do { _Pragma("unroll") for (int _i = 0; _i < 2; ++_i) \
        __builtin_amdgcn_global_load_lds((const unsigned*)((const char*)(gbase) + (voff)[_i]), (PG8_LAS unsigned*)(lds + (bufoff) + ldsw + _i * 8192), 16, 0, 0); } while (0)
#define PG8_LDA(dst, b, h) do { _Pragma("unroll") for (int m = 0; m < 4; ++m) _Pragma("unroll") for (int k = 0; k < 2; ++k) dst[m][k] = *(const PG8_LAS bf16x8*)(lds + PG8_SA(b, h) + aoff + m * 2048 + k * 1024); } while (0)
#define PG8_LDB(dst, b, h) do { _Pragma("unroll") for (int n = 0; n < 2; ++n) _Pragma("unroll") for (int k = 0; k < 2; ++k) dst[n][k] = *(const PG8_LAS bf16x8*)(lds + PG8_SB(b, h) + boff + n * 2048 + k * 1024); } while (0)
#define PG8_MMA(ai, bj, At, Bt) do { __builtin_amdgcn_s_setprio(1); _Pragma("unroll") for (int m = 0; m < 4; ++m) _Pragma("unroll") for (int n = 0; n < 2; ++n) _Pragma("unroll") for (int k = 0; k < 2; ++k) \
        acc[ai][bj][m][n] = __builtin_amdgcn_mfma_f32_16x16x32_bf16(Bt[n][k], At[m][k], acc[ai][bj][m][n], 0, 0, 0); __builtin_amdgcn_s_setprio(0); } while (0)
#define PG8_WAIT_V(n) asm volatile("s_waitcnt vmcnt(" #n ")" ::: "memory")
#define PG8_WAIT_L(n) asm volatile("s_waitcnt lgkmcnt(" #n ")" ::: "memory")
#define PG8_BAR __builtin_amdgcn_s_barrier()
#define PG8_SCHED __builtin_amdgcn_sched_barrier(0)
    Unit cur, nxt; int ui = 0;
    if (!S.next(0, cur)) return;
    f32x4 acc[2][2][4][2];
#pragma unroll
    for (int a = 0; a < 2; ++a)
#pragma unroll
        for (int b = 0; b < 2; ++b)
#pragma unroll
            for (int m = 0; m < 4; ++m)
#pragma unroll
                for (int n = 0; n < 2; ++n) acc[a][b][m][n] = (f32x4){0.f, 0.f, 0.f, 0.f};
    bf16x8 At[4][2], B0[2][2], B1[2][2];
    const char* cA = (const char*)g.A + (size_t)cur.pm * tstep; const char* cB = (const char*)g.Bt + (size_t)cur.pn * tstep;
    S.a_ready(cur);
    PG8_STAGE(PG8_SB(0, 0), cB, voffB); PG8_STAGE(PG8_SA(0, 0), cA, voffA); PG8_STAGE(PG8_SB(0, 1), cB + hstep, voffB); PG8_STAGE(PG8_SA(0, 1), cA + hstep, voffA);
    if (wr == 1) PG8_BAR;
    PG8_WAIT_V(4); PG8_BAR;
    PG8_STAGE(PG8_SB(1, 0), cB + kstep, voffB); PG8_STAGE(PG8_SA(1, 0), cA + kstep, voffA); PG8_STAGE(PG8_SB(1, 1), cB + hstep + kstep, voffB);
    PG8_WAIT_V(6); PG8_BAR;
    PG8_STAMP();
    for (;;) {
        const bool has_next = S.next(ui + 1, nxt);
        const char* nA = has_next ? (const char*)g.A + (size_t)nxt.pm * tstep : cA; const char* nB = has_next ? (const char*)g.Bt + (size_t)nxt.pn * tstep : cB;
        for (int t = 0; t < nt; t += 2) {
            const bool last = (t == nt - 2);
            const char* a1 = cA + (size_t)(t + 1) * kstep;
            const char* a2 = last ? nA : cA + (size_t)(t + 2) * kstep; const char* b2 = last ? nB : cB + (size_t)(t + 2) * kstep;
            const char* a3 = a2 + kstep; const char* b3 = b2 + kstep;
            if (last && has_next) S.a_ready(nxt);
            if constexpr (Epi::HAS_MID) { if (t == (nt >> 1)) E.mid(acc, cur, wr, wc, fr, fq); }
            PG8_LDB(B0, 0, 0); PG8_SCHED; PG8_LDA(At, 0, 0); PG8_STAGE(PG8_SA(1, 1), a1 + hstep, voffA);
            PG8_WAIT_L(8); PG8_BAR; PG8_WAIT_L(0); PG8_MMA(0, 0, At, B0); PG8_BAR; PG8_SCHED;
            PG8_LDB(B1, 0, 1); PG8_STAGE(PG8_SB(0, 0), b2, voffB);
            PG8_BAR; PG8_WAIT_L(0); PG8_MMA(0, 1, At, B1); PG8_BAR;
            PG8_LDA(At, 0, 1); PG8_STAGE(PG8_SA(0, 0), a2, voffA);
            PG8_BAR; PG8_WAIT_L(0); PG8_MMA(1, 0, At, B0); PG8_BAR; PG8_SCHED;
            PG8_STAGE(PG8_SB(0, 1), b2 + hstep, voffB);
            PG8_WAIT_V(6); PG8_BAR; PG8_MMA(1, 1, At, B1); PG8_BAR;
            PG8_LDB(B0, 1, 0); PG8_SCHED; PG8_LDA(At, 1, 0); PG8_STAGE(PG8_SA(0, 1), a2 + hstep, voffA);
            PG8_WAIT_L(8); PG8_BAR; PG8_WAIT_L(0); PG8_MMA(0, 0, At, B0); PG8_BAR; PG8_SCHED;
            PG8_LDB(B1, 1, 1); PG8_STAGE(PG8_SB(1, 0), b3, voffB);
            PG8_BAR; PG8_WAIT_L(0); PG8_MMA(0, 1, At, B1); PG8_BAR;
            PG8_LDA(At, 1, 1); PG8_STAGE(PG8_SA(1, 0), a3, voffA);
            PG8_BAR; PG8_WAIT_L(0); PG8_MMA(1, 0, At, B0); PG8_BAR; PG8_SCHED;
            PG8_STAGE(PG8_SB(1, 1), b3 + hstep, voffB);
            PG8_WAIT_V(6); PG8_BAR; PG8_MMA(1, 1, At, B1); PG8_BAR;
        }
        PG8_STAMP();
        if constexpr (!Epi::AFTER_DRAIN) { E(acc, cur, wr, wc, fr, fq); S.done(cur); }
        PG8_STAMP();
        if (!has_next) break;
#pragma unroll
        for (int a = 0; a < 2; ++a)
#pragma unroll
            for (int b = 0; b < 2; ++b)
#pragma unroll
                for (int m = 0; m < 4; ++m)
#pragma unroll
                    for (int n = 0; n < 2; ++n) acc[a][b][m][n] = (f32x4){0.f, 0.f, 0.f, 0.f};
        cur = nxt; cA = nA; cB = nB; ++ui;
    }
    PG8_WAIT_V(0);
    if (wr == 0) PG8_BAR;
    PG8_BAR;
    if constexpr (Epi::AFTER_DRAIN) { E.fused(acc, cur, wr, wc, fr, fq, lds, wid, lane); S.done(cur); }
    PG8_STAMP();
    if (STAMP && wid == 0) { stamps[lane] = lane < nts ? (((unsigned long long)(unsigned)ts_hi << 32) | (unsigned)ts_lo) : 0ull;
        if (lane == 62) stamps[62] = rt_entry; if (lane == 63) stamps[63] = (unsigned long long)wall_clock64(); }
#undef PG8_STAMP
#undef PG8_SA
#undef PG8_SB
#undef PG8_STAGE
#undef PG8_LDA
#undef PG8_LDB
#undef PG8_MMA
#undef PG8_WAIT_V
#undef PG8_WAIT_L
#undef PG8_BAR
#undef PG8_SCHED
}
}


using pg8::bf16_t; using pg8::bf16x8; using pg8::f32x4; using pg8::Unit; using pg8::Gemm; using pg8::StaticOrder;

struct MergeOrder : StaticOrder {
    int pass;
    __device__ __forceinline__ bool next(int i, Unit& u) const {
        const int X = nwg - G; const bool special = (X > 0 && 2 * X <= G);
        long L;
        if (!special) { L = (long)i * G + c; if (L >= nwg) return false; }
        else if (i == 0) L = c;
        else if (i == 1 && pass == 0 && c < X) L = G + c;
        else if (i == 1 && pass == 1 && c >= X && c < 2 * X) L = G + (c - X);
        else return false;
        int wgid = (int)L; { const int q = nwg / pg8::NXCD, r = nwg % pg8::NXCD, xcd = wgid % pg8::NXCD, off = wgid / pg8::NXCD; wgid = (xcd < r ? xcd * (q + 1) : r * (q + 1) + (xcd - r) * q) + off; }
        const int nig = pg8::WGM * nN, gid = wgid / nig, fm = gid * pg8::WGM, gsz = (nM - fm) < pg8::WGM ? (nM - fm) : pg8::WGM;
        u.pm = fm + ((wgid % nig) % gsz); u.pn = (wgid % nig) / gsz; u.tag = (special && L >= G) ? (int)(L - G) : -1; return true;
    }
};

constexpr int DM = 1024, NB = 8, SEQ = 2048, NMETA = 16, TP = SEQ + NMETA, DB = 128, DS = 4, NH = 8;
constexpr int MPROWS = NB * TP;
constexpr int MREAL = MPROWS + DB * DS;
constexpr int MPAD = 17152;
constexpr int NIN = 10256, QKVD = 3072;
constexpr int NCPS = 33, NCHUNK = NB * NH * NCPS;
constexpr float EPSF = 1e-6f;
constexpr size_t O_YP = 0, O_YS = 16777216, O_CAP = 17301504, O_CQP = 17317888, O_DP = 17391616, O_CAS = 18440192, O_CQS = 18702336, O_DSM = 19881984;
constexpr size_t WS_WTA = 0, WS_WTB = 2097152, WS_WTO = 4194304, WS_BETA = 6291456, WS_G = 6840320, WS_SSQ = 7389184, WS_EG = 11780096, WS_OS = 11788544, WS_BAR = 12845056,
                 WS_XN = 13631488, WS_WTIN = 48758784, WS_QKV = 70254592, WS_YA = WS_QKV, WS_YB = WS_QKV + 35127296, WS_MERGED = WS_QKV + 70254592,
                 WS_CHA = 175636480, WS_UB = WS_CHA, WS_BZ = WS_CHA + 35127296, WS_GA = WS_CHA, WS_GB = WS_CHA + 35127296;
constexpr int CH_REC = 73728, CH_IN_WS = 1258;
constexpr int LDS_BYTES = 139264 + 16;

struct P {
    const float *x_prompt, *x_sample, *st_conv_a, *st_conv_qkv, *st_delta, *meta, *norm_pre, *norm_post, *w_in, *b_gate,
                *conv_a_w, *conv_qkv_w, *a_log, *dt_bias, *gnorm_w, *w_a_out, *w_b_out, *w_o;
    float* out; unsigned char* ws;
};

__device__ __forceinline__ float bf2f(unsigned b) { return __uint_as_float(b << 16); }
typedef float f32x2_t __attribute__((ext_vector_type(2)));
typedef __bf16 bf16x2_t __attribute__((ext_vector_type(2)));
__device__ __forceinline__ unsigned pk2(float lo, float hi) { const f32x2_t v = {lo, hi}; const bf16x2_t b = __builtin_convertvector(v, bf16x2_t); return __builtin_bit_cast(unsigned, b); }
__device__ __forceinline__ float sigm(float x) { return __builtin_amdgcn_rcpf(1.f + __expf(-x)); }
__device__ __forceinline__ float silu(float x) { return x * __builtin_amdgcn_rcpf(1.f + __expf(-x)); }
typedef unsigned u32x4_t __attribute__((ext_vector_type(4)));
typedef unsigned u32x2_t __attribute__((ext_vector_type(2)));
__device__ __forceinline__ uint4 ldnt16(const void* p) { const u32x4_t t = __builtin_nontemporal_load((const u32x4_t*)p); return make_uint4(t[0], t[1], t[2], t[3]); }
__device__ __forceinline__ uint2 ldnt8(const void* p) { const u32x2_t t = __builtin_nontemporal_load((const u32x2_t*)p); return make_uint2(t[0], t[1]); }
__device__ __forceinline__ void stnt16f(float* p, float a, float b, float c, float d) { const f32x4 t = {a, b, c, d}; __builtin_nontemporal_store(t, (f32x4*)p); }
__device__ __forceinline__ f32x4 mfma16(bf16x8 a, bf16x8 b, f32x4 c) { return __builtin_amdgcn_mfma_f32_16x16x32_bf16(a, b, c, 0, 0, 0); }
__device__ __forceinline__ void unpack8(uint4 v, float* f) {
    f[0] = bf2f(v.x & 0xffffu); f[1] = bf2f(v.x >> 16); f[2] = bf2f(v.y & 0xffffu); f[3] = bf2f(v.y >> 16);
    f[4] = bf2f(v.z & 0xffffu); f[5] = bf2f(v.z >> 16); f[6] = bf2f(v.w & 0xffffu); f[7] = bf2f(v.w >> 16);
}
__device__ __forceinline__ unsigned char* chunk_rec(const P& p, int ci) {
    return ci < CH_IN_WS ? p.ws + WS_CHA + (size_t)ci * CH_REC : (unsigned char*)p.out + (size_t)(ci - CH_IN_WS) * CH_REC;
}

__device__ __forceinline__ int wtin_col(int c) {
    if (c >= 3072) { if (c < 3328) return (c - 3072 < 16) ? 8192 + (c - 3072) : -1; c -= 256; }
    if (c < 4096) { const int g = c & ~31, w = c & 31, n = (w >> 4) & 1, fq = (w >> 2) & 3, j = w & 3; return 4096 + g + 8 * fq + 4 * n + j; }
    if (c < 8192) { const int rel = c - 4096, tile = rel >> 8, w = rel & 255, bj = w >> 7, wc = (w >> 5) & 3, n = (w >> 4) & 1, fq = (w >> 2) & 3, j = w & 3;
        const int type = (tile >> 3) * 2 + n, ch = 128 * (tile & 7) + 32 * wc + 8 * fq + 4 * bj + j; const int off = type == 0 ? 0 : (type == 1 ? 2048 : (type == 2 ? 1024 : 3072)); return off + ch; }
    { const int rel = c - 8192, g = rel & ~31, w = rel & 31, n = (w >> 4) & 1, fq = (w >> 2) & 3, j = w & 3; return 8208 + g + 8 * fq + 4 * n + j; }
}

__device__ __forceinline__ void phase0(const P& p, unsigned char* smem) {
    const int tid = threadIdx.x, lane = tid & 63, wid = tid >> 6;
    float* tileS = (float*)smem;
    {
        constexpr int NTILES = 1312 + 128 * 3;
        auto tparams = [&](const int tile, const float*& src, int& ld, int& n0, int& k0, int& mode, bf16_t*& dst) __attribute__((always_inline)) {
            if (tile < 1312) { mode = 0; n0 = (tile >> 3) * 64; k0 = (tile & 7) * 128; src = p.w_in; ld = NIN; dst = (bf16_t*)(p.ws + WS_WTIN); }
            else { const int t = (tile - 1312) & 127, w = (tile - 1312) >> 7; mode = 1; n0 = (t >> 3) * 64; k0 = (t & 7) * 128; src = w == 0 ? p.w_a_out : (w == 1 ? p.w_b_out : p.w_o); ld = 1024;
                dst = (bf16_t*)(p.ws + (w == 0 ? WS_WTA : (w == 1 ? WS_WTB : WS_WTO))); }
        };
        float v[16];
        auto tload = [&](const int tile) __attribute__((always_inline)) {
            const float* src; int ld, n0, k0, mode; bf16_t* dst; tparams(tile, src, ld, n0, k0, mode, dst);
            const int nn = tid & 63; const int col = mode == 0 ? wtin_col(n0 + nn) : (n0 + nn);
#pragma unroll
            for (int i = 0; i < 16; ++i) { const int kk = (tid >> 6) + 8 * i; v[i] = col >= 0 ? __builtin_nontemporal_load(src + (size_t)(k0 + kk) * ld + col) : 0.f; }
        };
        if ((int)blockIdx.x < NTILES) tload(blockIdx.x);
        int par = 0;
        for (int tile = blockIdx.x; tile < NTILES; tile += gridDim.x, par ^= 1) {
            const float* src; int ld, n0, k0, mode; bf16_t* dst; tparams(tile, src, ld, n0, k0, mode, dst);
            float* tb = tileS + par * (128 * 65);
            { const int nn = tid & 63;
#pragma unroll
              for (int i = 0; i < 16; ++i) { const int kk = (tid >> 6) + 8 * i; tb[kk * 65 + nn] = v[i]; } }
            if (tile + (int)gridDim.x < NTILES) tload(tile + gridDim.x);
            __syncthreads();
            {
                const int nn = tid >> 3, kq = tid & 7; float f[16];
#pragma unroll
                for (int j = 0; j < 16; ++j) f[j] = tb[(kq * 16 + j) * 65 + nn];
                uint4 o0, o1; o0.x = pk2(f[0], f[1]); o0.y = pk2(f[2], f[3]); o0.z = pk2(f[4], f[5]); o0.w = pk2(f[6], f[7]); o1.x = pk2(f[8], f[9]); o1.y = pk2(f[10], f[11]); o1.z = pk2(f[12], f[13]); o1.w = pk2(f[14], f[15]);
                bf16_t* d = dst + (size_t)(n0 + nn) * 1024 + k0 + kq * 16; *(uint4*)d = o0; *(uint4*)(d + 8) = o1;
            }
        }
        __syncthreads();
    }
    bf16_t* xn = (bf16_t*)(p.ws + WS_XN);
    float4 xpre[4];
    auto rowload = [&](const int r) __attribute__((always_inline)) {
        if (r < MREAL) { const float* src;
            if (r < MPROWS) { const int b = r / TP, t = r - b * TP; src = (t < NMETA) ? p.meta + (size_t)t * DM : p.x_prompt + ((size_t)b * SEQ + (t - NMETA)) * DM; }
            else src = p.x_sample + (size_t)(r - MPROWS) * DM;
#pragma unroll
            for (int i = 0; i < 4; ++i) { const f32x4 t_ = __builtin_nontemporal_load((const f32x4*)(src + i * 256 + lane * 4)); xpre[i] = make_float4(t_[0], t_[1], t_[2], t_[3]); } }
    };
    rowload(blockIdx.x * 8 + wid);
    for (int r = blockIdx.x * 8 + wid; r < MPAD; r += gridDim.x * 8) {
        if (r >= MREAL) {
#pragma unroll
            for (int i = 0; i < 4; ++i) *(uint2*)(xn + (size_t)r * 1024 + i * 256 + lane * 4) = make_uint2(0u, 0u);
            continue;
        }
        float x[16]; float ssq = 0.f;
#pragma unroll
        for (int i = 0; i < 4; ++i) { const float4 v = xpre[i]; x[i * 4 + 0] = v.x; x[i * 4 + 1] = v.y; x[i * 4 + 2] = v.z; x[i * 4 + 3] = v.w;
            ssq += v.x * v.x + v.y * v.y + v.z * v.z + v.w * v.w; }
        rowload(r + gridDim.x * 8);
#pragma unroll
        for (int m = 32; m >= 1; m >>= 1) ssq += __shfl_xor(ssq, m);
        const float rs = rsqrtf(ssq * (1.f / 1024.f) + EPSF);
#pragma unroll
        for (int i = 0; i < 4; ++i) { const float4 w = *(const float4*)(p.norm_pre + i * 256 + lane * 4);
            x[i * 4 + 0] *= rs * w.x; x[i * 4 + 1] *= rs * w.y; x[i * 4 + 2] *= rs * w.z; x[i * 4 + 3] *= rs * w.w;
            *(uint2*)(xn + (size_t)r * 1024 + i * 256 + lane * 4) = make_uint2(pk2(x[i * 4 + 0], x[i * 4 + 1]), pk2(x[i * 4 + 2], x[i * 4 + 3])); }
    }
}

struct EpiIn {
    static constexpr bool PERM = false, AFTER_DRAIN = false, HAS_MID = false;
    int mode; int dry; const P* pp;
    __device__ __forceinline__ void operator()(const f32x4 (&acc)[2][2][4][2], const Unit& u, int wr, int wc, int fr, int fq) const {
        const int row0 = u.pm * 256 + wr * 64 + fr;
        if (mode == 0 && u.pn == 12) {
            if (wc == 0) { float* betab = (float*)(pp->ws + WS_BETA); float* gb = (float*)(pp->ws + WS_G);
                float4 al = make_float4(0.f, 0.f, 0.f, 0.f), db = al;
                if (fq >= 2) { al = *(const float4*)(pp->a_log + 4 * (fq - 2)); db = *(const float4*)(pp->dt_bias + 4 * (fq - 2)); }
#pragma unroll
                for (int ai = 0; ai < 2; ++ai)
#pragma unroll
                    for (int m = 0; m < 4; ++m) { const int row = row0 + ai * 128 + m * 16; const f32x4 v = acc[ai][0][m][0];
                        if (fq < 2) *(float4*)(betab + (size_t)row * 8 + 4 * fq) = make_float4(sigm(v[0]), sigm(v[1]), sigm(v[2]), sigm(v[3]));
                        else { const float z0 = v[0] + db.x, z1 = v[1] + db.y, z2 = v[2] + db.z, z3 = v[3] + db.w;
                            *(float4*)(gb + (size_t)row * 8 + 4 * (fq - 2)) = make_float4(-__expf(al.x) * (z0 > 20.f ? z0 : __logf(1.f + __expf(z0))), -__expf(al.y) * (z1 > 20.f ? z1 : __logf(1.f + __expf(z1))),
                                                                                       -__expf(al.z) * (z2 > 20.f ? z2 : __logf(1.f + __expf(z2))), -__expf(al.w) * (z3 > 20.f ? z3 : __logf(1.f + __expf(z3)))); } } }
        } else if (mode == 0) {
            bf16_t* qkv = (bf16_t*)(pp->ws + WS_QKV);
#pragma unroll
            for (int ai = 0; ai < 2; ++ai)
#pragma unroll
                for (int m = 0; m < 4; ++m) { const int row = row0 + ai * 128 + m * 16; {
#pragma unroll
                    for (int bj = 0; bj < 2; ++bj) { const int oc = u.pn * 256 + bj * 128 + wc * 32 + 8 * fq; const f32x4 v0 = acc[ai][bj][m][0], v1 = acc[ai][bj][m][1];
                        uint4 o; o.x = pk2(v0[0], v0[1]); o.y = pk2(v0[2], v0[3]); o.z = pk2(v1[0], v1[1]); o.w = pk2(v1[2], v1[3]);
                        *(uint4*)(qkv + (size_t)row * QKVD + oc) = o; } } }
        } else if (mode == 1) {
            if (u.pn >= 20) gates(acc, u.pn - 20, row0, wc, fq);
            else if (u.pn < 4) {
                bf16_t* Z = (bf16_t*)(pp->ws + WS_YA);
#pragma unroll
                for (int ai = 0; ai < 2; ++ai)
#pragma unroll
                    for (int m = 0; m < 4; ++m) { const int row = row0 + ai * 128 + m * 16;
#pragma unroll
                        for (int bj = 0; bj < 2; ++bj) { const int oc = u.pn * 256 + bj * 128 + wc * 32 + 8 * fq; const f32x4 v0 = acc[ai][bj][m][0], v1 = acc[ai][bj][m][1];
                            uint4 o; o.x = pk2(silu(v0[0]), silu(v0[1])); o.y = pk2(silu(v0[2]), silu(v0[3])); o.z = pk2(silu(v1[0]), silu(v1[1])); o.w = pk2(silu(v1[2]), silu(v1[3]));
                            *(uint4*)(Z + (size_t)row * 1024 + oc) = o; } }
            } else {
                const int tile = u.pn - 4; bf16_t* dstb = (tile < 8) ? (bf16_t*)pp->out : (bf16_t*)(pp->ws + WS_MERGED);
                const int ch = 128 * (tile & 7) + 32 * wc + 8 * fq;
#pragma unroll
                for (int ai = 0; ai < 2; ++ai)
#pragma unroll
                    for (int m = 0; m < 4; ++m) { const int row = row0 + ai * 128 + m * 16;
                        const f32x4 x0 = acc[ai][0][m][0], x1 = acc[ai][1][m][0], y0 = acc[ai][0][m][1], y1 = acc[ai][1][m][1];
                        uint4 o;
                        if (tile < 8) { o.x = pk2(x0[0] * y0[0], x0[1] * y0[1]); o.y = pk2(x0[2] * y0[2], x0[3] * y0[3]); o.z = pk2(x1[0] * y1[0], x1[1] * y1[1]); o.w = pk2(x1[2] * y1[2], x1[3] * y1[3]); }
                        else { o.x = pk2(x0[0] * silu(y0[0]), x0[1] * silu(y0[1])); o.y = pk2(x0[2] * silu(y0[2]), x0[3] * silu(y0[3])); o.z = pk2(x1[0] * silu(y1[0]), x1[1] * silu(y1[1])); o.w = pk2(x1[2] * silu(y1[2]), x1[3] * silu(y1[3])); }
                        *(uint4*)(dstb + (size_t)row * 1024 + ch) = o; }
            }
        }
    }
    __device__ __forceinline__ void gates(const f32x4 (&acc)[2][2][4][2], const int pn, const int row0, const int wc, const int fq) const {
        bf16_t* G = (bf16_t*)(pp->ws + (pn < 4 ? WS_GA : WS_GB));
#pragma unroll
        for (int bj = 0; bj < 2; ++bj) { const int oc = 256 * pn + 128 * bj + 32 * wc + 8 * fq;
            const float4 b0 = *(const float4*)(pp->b_gate + oc), b1 = *(const float4*)(pp->b_gate + oc + 4);
#pragma unroll
            for (int ai = 0; ai < 2; ++ai)
#pragma unroll
                for (int m = 0; m < 4; ++m) { const int row = row0 + ai * 128 + m * 16; const f32x4 v0 = acc[ai][bj][m][0], v1 = acc[ai][bj][m][1];
                    uint4 o; o.x = pk2(sigm(v0[0] + b0.x), sigm(v0[1] + b0.y)); o.y = pk2(sigm(v0[2] + b0.z), sigm(v0[3] + b0.w)); o.z = pk2(sigm(v1[0] + b1.x), sigm(v1[1] + b1.y)); o.w = pk2(sigm(v1[2] + b1.z), sigm(v1[3] + b1.w));
                    *(uint4*)(G + (size_t)row * 1024 + (oc & 1023)) = o; } }
    }
};

struct EpiMerge {
    static constexpr bool PERM = false, AFTER_DRAIN = false, HAS_MID = false;
    int pass; const P* pp;
    __device__ __forceinline__ void operator()(const f32x4 (&acc)[2][2][4][2], const Unit& u, int wr, int wc, int fr, int fq) const {
        const bf16_t* G = (const bf16_t*)(pp->ws + (pass ? WS_GB : WS_GA)); bf16_t* Mg = (bf16_t*)(pp->ws + WS_MERGED);
        unsigned* flag = (unsigned*)(pp->ws + WS_BAR) + 3456 + 16 + (u.tag >= 0 ? u.tag : 0);
        const int row0 = u.pm * 256 + wr * 64 + fr, col0 = u.pn * 256 + wc * 32 + 4 * fq;
        if (pass && u.tag >= 0) {
            unsigned spins = 0;
            while ((unsigned)__builtin_amdgcn_readfirstlane(__hip_atomic_load(flag, __ATOMIC_RELAXED, __HIP_MEMORY_SCOPE_AGENT)) < 8u && ++spins < (1u << 22)) __builtin_amdgcn_s_sleep(2);
            __builtin_amdgcn_fence(__ATOMIC_ACQUIRE, "agent");
            asm volatile("s_waitcnt vmcnt(0)" ::: "memory");
        }
#pragma unroll
        for (int ai = 0; ai < 2; ++ai)
#pragma unroll
            for (int m = 0; m < 4; ++m)
#pragma unroll
                for (int bj = 0; bj < 2; ++bj)
#pragma unroll
                    for (int n = 0; n < 2; ++n) { const size_t off = (size_t)(row0 + ai * 128 + m * 16) * 1024 + col0 + bj * 128 + n * 16; const uint2 v = *(const uint2*)(G + off);
                        const f32x4 a = acc[ai][bj][m][n];
                        float r0 = a[0] * bf2f(v.x & 0xffffu), r1 = a[1] * bf2f(v.x >> 16), r2 = a[2] * bf2f(v.y & 0xffffu), r3 = a[3] * bf2f(v.y >> 16);
                        if (pass) { const uint2 o = *(const uint2*)(Mg + off); r0 += bf2f(o.x & 0xffffu); r1 += bf2f(o.x >> 16); r2 += bf2f(o.y & 0xffffu); r3 += bf2f(o.y >> 16); }
                        *(uint2*)(Mg + off) = make_uint2(pk2(r0, r1), pk2(r2, r3)); }
        if (!pass && u.tag >= 0) {
            asm volatile("s_waitcnt vmcnt(0)" ::: "memory");
            __builtin_amdgcn_fence(__ATOMIC_RELEASE, "agent");
            asm volatile("s_waitcnt vmcnt(0)" ::: "memory");
            if (fr == 0 && fq == 0) __hip_atomic_fetch_add(flag, 1u, __ATOMIC_RELAXED, __HIP_MEMORY_SCOPE_AGENT);
        }
    }
};

struct EpiPre {
    static constexpr bool PERM = false, AFTER_DRAIN = false, HAS_MID = false;
    const P* pp;
    __device__ __forceinline__ void operator()(const f32x4 (&acc)[2][2][4][2], const Unit& u, int wr, int wc, int fr, int fq) const {
        const int row0 = u.pm * 256 + wr * 64 + fr, col0 = u.pn * 256 + wc * 32 + 4 * fq;
#pragma unroll
        for (int ai = 0; ai < 2; ++ai)
#pragma unroll
            for (int m = 0; m < 4; ++m) { const int row = row0 + ai * 128 + m * 16; float* dst = nullptr;
                if (row < MPROWS) { const int b = row / TP, t = row - b * TP; if (t >= NMETA) dst = pp->out + O_YP + ((size_t)b * SEQ + (t - NMETA)) * DM; }
                else if (row < MREAL) dst = pp->out + O_YS + (size_t)(row - MPROWS) * DM;
                if (dst) {
#pragma unroll
                    for (int bj = 0; bj < 2; ++bj)
#pragma unroll
                        for (int n = 0; n < 2; ++n) { const f32x4 a = acc[ai][bj][m][n]; *(uint2*)((bf16_t*)dst + col0 + bj * 128 + n * 16) = make_uint2(pk2(a[0], a[1]), pk2(a[2], a[3])); } } }
    }
};


template <int N> __device__ __forceinline__ void tri_merge(const float* Am, float* Tm, float* M1, int tid) {
    constexpr int TOT = (32 / N) * N * N;
    for (int o = tid; o < TOT; o += 512) { const int pr = o / (N * N), i = (o / N) % N, j = o % N, base = pr * 2 * N; float s = 0.f;
#pragma unroll 8
        for (int k = 0; k < N; ++k) s += Am[(base + N + i) * 68 + base + k] * Tm[(base + k) * 68 + base + j];
        M1[(pr * N + i) * 36 + j] = s; }
    __syncthreads();
    for (int o = tid; o < TOT; o += 512) { const int pr = o / (N * N), i = (o / N) % N, j = o % N, base = pr * 2 * N; float s = 0.f;
#pragma unroll 8
        for (int k = 0; k < N; ++k) s += Tm[(base + N + i) * 68 + base + N + k] * M1[(pr * N + k) * 36 + j];
        Tm[(base + N + i) * 68 + base + j] = -s; }
    __syncthreads();
}

__device__ __forceinline__ void phase2(const P& p, unsigned char* smem, const int parts) {
    int tid_2 = threadIdx.x; asm volatile("" : "+v"(tid_2));
    const int tid = tid_2, lane = tid & 63, wid = tid >> 6, fr = lane & 15, fq = lane >> 4;
    float* Gs = (float*)smem; float* Bs = (float*)(smem + 256);
    bf16_t* kS = (bf16_t*)(smem + 512); bf16_t* qS = kS + 64 * 136; bf16_t* vbT = qS + 64 * 136; bf16_t* kbgT = vbT + 128 * 72; bf16_t* kdT = kbgT + 128 * 72;
    float* Am = (float*)(kdT + 128 * 72); float* Tm = Am + 64 * 68; float* M1 = Tm + 64 * 68; bf16_t* Tb = (bf16_t*)(M1 + 32 * 36);
    const bf16_t* qkv = (const bf16_t*)(p.ws + WS_QKV);
    const float* betab = (const float*)(p.ws + WS_BETA); const float* gbuf = (const float*)(p.ws + WS_G);
    float* egb = (float*)(p.ws + WS_EG);
#ifndef P2_PARTS
#define P2_PARTS 3
#endif
    unsigned xr[3][11]; float2 wv[3][4]; float gpre = 0.f, bpre = 0.f;
    auto load_raw = [&](const int cj, const int lane_, const int wid_, const int tid_) __attribute__((always_inline)) {
        const int bh2 = cj / NCPS, c2 = cj - bh2 * NCPS, b2 = bh2 >> 3, h2 = bh2 & 7; const int t02 = c2 == 0 ? 0 : NMETA + 64 * (c2 - 1), L2 = c2 == 0 ? NMETA : 64;
#pragma unroll
        for (int s = 0; s < 3; ++s) { const int col = s * 1024 + h2 * 128 + 2 * lane_;
#pragma unroll
            for (int j = 0; j < 4; ++j) wv[s][j] = *(const float2*)(p.conv_qkv_w + j * QKVD + col);
#pragma unroll
            for (int i = 0; i < 11; ++i) { const int tt = t02 + 8 * wid_ - 3 + i; xr[s][i] = *(const unsigned*)(qkv + (size_t)(b2 * TP + (tt >= 0 ? tt : 0)) * QKVD + col); } }
        if (tid_ < 64) { const int r = b2 * TP + t02 + (tid_ < L2 ? tid_ : 0); gpre = gbuf[(size_t)r * 8 + h2]; bpre = betab[(size_t)r * 8 + h2]; }
    };
    if ((parts & 1) && (int)blockIdx.x < NCHUNK) load_raw(blockIdx.x, lane, wid, tid);
    for (int ci = blockIdx.x; ci < ((parts & 1) ? NCHUNK : 0); ci += gridDim.x) {
        int tid_l = tid_2; asm volatile("" : "+v"(tid_l));
        const int tid = tid_l, lane = tid & 63, wid = tid >> 6, fr = lane & 15, fq = lane >> 4;
        const int bh = ci / NCPS, c = ci - bh * NCPS, b = bh >> 3, h = bh & 7;
        const int t0 = c == 0 ? 0 : NMETA + 64 * (c - 1), L = c == 0 ? NMETA : 64;
        const int rb = b * TP + t0;
        unsigned char* rec = chunk_rec(p, ci);
        if (tid < 64) {
            float gv = (tid < L) ? gpre : 0.f; const float bv = (tid < L) ? bpre : 0.f;
#pragma unroll
            for (int d = 1; d < 64; d <<= 1) { const float o = __shfl_up(gv, d); if (lane >= d) gv += o; }
            Gs[tid] = gv; Bs[tid] = bv;
        }
        for (int i = tid; i < 64 * 68; i += 512) Tm[i] = 0.f;
        __syncthreads();
        for (int rA = 0; rA < 1 + ((BLK_RPT >> 0) & 1) * 4; ++rA) {
            if (rA) __syncthreads();
            const int cp = lane, tb = 8 * wid;
            float eG[8], eD[8], bt[8];
            { const float Gl = Gs[63];
#pragma unroll
              for (int tk = 0; tk < 8; ++tk) { const float Gt = Gs[tb + tk]; eG[tk] = __expf(Gt); eD[tk] = __expf(Gl - Gt); bt[tk] = Bs[tb + tk]; } }
#pragma unroll
            for (int s = 0; s < 3; ++s) {
                float2 w[4];
#pragma unroll
                for (int j = 0; j < 4; ++j) w[j] = wv[s][j];
                float xa[11], xb[11];
#pragma unroll
                for (int i = 0; i < 11; ++i) { const int tt = t0 + tb - 3 + i; const unsigned v = xr[s][i];
                    const float m = tt >= 0 ? 1.f : 0.f; xa[i] = bf2f(v & 0xffffu) * m; xb[i] = bf2f(v >> 16) * m; }
                if (s == 2 && ci + (int)gridDim.x < NCHUNK) load_raw(ci + gridDim.x, lane, wid, tid);
                float ya[8], yb[8], sq[8];
#pragma unroll
                for (int tk = 0; tk < 8; ++tk) { float a = 0.f, c = 0.f;
#pragma unroll
                    for (int j = 0; j < 4; ++j) { a += w[j].x * xa[tk + j]; c += w[j].y * xb[tk + j]; }
                    const bool valid = (tb + tk) < L; ya[tk] = valid ? silu(a) : 0.f; yb[tk] = valid ? silu(c) : 0.f; sq[tk] = ya[tk] * ya[tk] + yb[tk] * yb[tk]; }
                if (s < 2) {
#pragma unroll
                    for (int i = 0; i < 4; ++i) { const bool up = lane & 32; const float keep = up ? sq[i + 4] : sq[i], send = up ? sq[i] : sq[i + 4]; sq[i] = keep + __shfl_xor(send, 32); }
#pragma unroll
                    for (int i = 0; i < 2; ++i) { const bool up = lane & 16; const float keep = up ? sq[i + 2] : sq[i], send = up ? sq[i] : sq[i + 2]; sq[i] = keep + __shfl_xor(send, 16); }
                    { const bool up = lane & 8; const float keep = up ? sq[1] : sq[0], send = up ? sq[0] : sq[1]; sq[0] = keep + __shfl_xor(send, 8); }
                    sq[0] += __shfl_xor(sq[0], 4); sq[0] += __shfl_xor(sq[0], 2); sq[0] += __shfl_xor(sq[0], 1);
                    const float tot = sq[0];
#pragma unroll
                    for (int tk = 0; tk < 8; ++tk) { const float n2 = __shfl(tot, 32 * (tk >> 2) + 16 * ((tk >> 1) & 1) + 8 * (tk & 1));
                        const float rn = rsqrtf(n2 + EPSF) * (s == 0 ? 0.08838834764831845f : 1.f); ya[tk] *= rn; yb[tk] *= rn; }
                }
                if (s == 0) {
#pragma unroll
                    for (int tk = 0; tk < 8; ++tk) { *(unsigned*)(qS + (tb + tk) * 136 + 2 * cp) = pk2(ya[tk], yb[tk]);
                        if (REC_MASK & 1) *(unsigned*)(rec + 16384 + ((tb + tk) * 128 + 2 * cp) * 2) = pk2(ya[tk] * eG[tk], yb[tk] * eG[tk]); }
                } else if (s == 1) {
#pragma unroll
                    for (int tk = 0; tk < 8; ++tk) *(unsigned*)(kS + (tb + tk) * 136 + 2 * cp) = pk2(ya[tk], yb[tk]);
                    uint4 o;
                    o.x = pk2(ya[0] * bt[0] * eG[0], ya[1] * bt[1] * eG[1]); o.y = pk2(ya[2] * bt[2] * eG[2], ya[3] * bt[3] * eG[3]); o.z = pk2(ya[4] * bt[4] * eG[4], ya[5] * bt[5] * eG[5]); o.w = pk2(ya[6] * bt[6] * eG[6], ya[7] * bt[7] * eG[7]);
                    *(uint4*)(kbgT + (2 * cp) * 72 + tb) = o;
                    o.x = pk2(yb[0] * bt[0] * eG[0], yb[1] * bt[1] * eG[1]); o.y = pk2(yb[2] * bt[2] * eG[2], yb[3] * bt[3] * eG[3]); o.z = pk2(yb[4] * bt[4] * eG[4], yb[5] * bt[5] * eG[5]); o.w = pk2(yb[6] * bt[6] * eG[6], yb[7] * bt[7] * eG[7]);
                    *(uint4*)(kbgT + (2 * cp + 1) * 72 + tb) = o;
                    o.x = pk2(ya[0] * eD[0], ya[1] * eD[1]); o.y = pk2(ya[2] * eD[2], ya[3] * eD[3]); o.z = pk2(ya[4] * eD[4], ya[5] * eD[5]); o.w = pk2(ya[6] * eD[6], ya[7] * eD[7]);
                    *(uint4*)(kdT + (2 * cp) * 72 + tb) = o;
                    o.x = pk2(yb[0] * eD[0], yb[1] * eD[1]); o.y = pk2(yb[2] * eD[2], yb[3] * eD[3]); o.z = pk2(yb[4] * eD[4], yb[5] * eD[5]); o.w = pk2(yb[6] * eD[6], yb[7] * eD[7]);
                    *(uint4*)(kdT + (2 * cp + 1) * 72 + tb) = o;
                } else {
                    uint4 o;
                    o.x = pk2(ya[0] * bt[0], ya[1] * bt[1]); o.y = pk2(ya[2] * bt[2], ya[3] * bt[3]); o.z = pk2(ya[4] * bt[4], ya[5] * bt[5]); o.w = pk2(ya[6] * bt[6], ya[7] * bt[7]);
                    *(uint4*)(vbT + (2 * cp) * 72 + tb) = o;
                    o.x = pk2(yb[0] * bt[0], yb[1] * bt[1]); o.y = pk2(yb[2] * bt[2], yb[3] * bt[3]); o.z = pk2(yb[4] * bt[4], yb[5] * bt[5]); o.w = pk2(yb[6] * bt[6], yb[7] * bt[7]);
                    *(uint4*)(vbT + (2 * cp + 1) * 72 + tb) = o;
                }
            }
        }
        __syncthreads();
        {
#pragma unroll
            for (int i = 0; i < 2; ++i) { const int idx = tid * 2 + i, kch = idx >> 3, pc = idx & 7; if (REC_MASK & 2) *(uint4*)(rec + 32768 + (kch * 64 + pc * 8) * 2) = *(const uint4*)(kdT + kch * 72 + pc * 8); }
            if (tid == 0) egb[ci] = __expf(Gs[63]);
        }
        for (int rB = 0; rB < 1 + ((BLK_RPT >> 1) & 1) * 4; ++rB) {
            if (rB) __syncthreads();
            const int mt = wid & 3, sel = wid >> 2; const bf16_t* As = sel ? qS : kS;
            bf16x8 af[4];
#pragma unroll
            for (int kk = 0; kk < 4; ++kk) af[kk] = *(const bf16x8*)(As + (16 * mt + fr) * 136 + 32 * kk + 8 * fq);
#pragma unroll
            for (int nt = 0; nt < 4; ++nt) {
                f32x4 acc = {0.f, 0.f, 0.f, 0.f};
                if (nt <= mt) {
#pragma unroll
                    for (int kk = 0; kk < 4; ++kk) { const bf16x8 bb = *(const bf16x8*)(kS + (16 * nt + fr) * 136 + 32 * kk + 8 * fq); acc = sel ? mfma16(bb, af[kk], acc) : mfma16(af[kk], bb, acc); }
                }
                if (sel == 0) { const int j = 16 * nt + fr; const float Gj = Gs[j];
#pragma unroll
                    for (int jj = 0; jj < 4; ++jj) { const int i = 16 * mt + 4 * fq + jj; const float dec = (i >= j) ? __expf(Gs[i] - Gj) : 0.f; Am[i * 68 + j] = (i > j) ? Bs[i] * acc[jj] * dec : 0.f; }
                } else { const int i = 16 * mt + fr; const float Gi = Gs[i]; float a4[4];
#pragma unroll
                    for (int jj = 0; jj < 4; ++jj) { const int j = 16 * nt + 4 * fq + jj; a4[jj] = (i >= j) ? acc[jj] * __expf(Gi - Gs[j]) : 0.f; }
                    if (REC_MASK & 4) *(uint2*)(rec + 65536 + (i * 64 + 16 * nt + 4 * fq) * 2) = make_uint2(pk2(a4[0], a4[1]), pk2(a4[2], a4[3])); }
            }
        }
        __syncthreads();
        for (int rC = 0; rC < 1 + ((BLK_RPT >> 2) & 1) * 4; ++rC) if (wid == 0) {
            const int blk = lane >> 4, cc = lane & 15; float x[16];
#pragma unroll
            for (int i = 0; i < 16; ++i) { float s = (i == cc) ? 1.f : 0.f;
#pragma unroll
                for (int j = 0; j < i; ++j) s -= Am[(16 * blk + i) * 68 + 16 * blk + j] * x[j];
                x[i] = s; }
#pragma unroll
            for (int i = 0; i < 16; ++i) Tm[(16 * blk + i) * 68 + 16 * blk + cc] = x[i];
        }
        __syncthreads();
        {
            const int base = 32 * (wid & 1), mi = (wid >> 1) & 1, ni = wid & 1;
            if (wid < 2) { f32x4 acc = {0.f, 0.f, 0.f, 0.f};
#pragma unroll
                for (int ks = 0; ks < 4; ++ks) acc = __builtin_amdgcn_mfma_f32_16x16x4f32(Am[(base + 16 + fr) * 68 + base + 4 * ks + fq], Tm[(base + 4 * ks + fq) * 68 + base + fr], acc, 0, 0, 0);
#pragma unroll
                for (int j = 0; j < 4; ++j) M1[(16 * wid + 4 * fq + j) * 36 + fr] = acc[j]; }
            __syncthreads();
            if (wid < 2) { f32x4 acc = {0.f, 0.f, 0.f, 0.f};
#pragma unroll
                for (int ks = 0; ks < 4; ++ks) acc = __builtin_amdgcn_mfma_f32_16x16x4f32(Tm[(base + 16 + fr) * 68 + base + 16 + 4 * ks + fq], M1[(16 * wid + 4 * ks + fq) * 36 + fr], acc, 0, 0, 0);
#pragma unroll
                for (int j = 0; j < 4; ++j) Tm[(base + 16 + 4 * fq + j) * 68 + base + fr] = -acc[j]; }
            __syncthreads();
            if (wid < 4) { f32x4 acc = {0.f, 0.f, 0.f, 0.f};
#pragma unroll
                for (int ks = 0; ks < 8; ++ks) acc = __builtin_amdgcn_mfma_f32_16x16x4f32(Am[(32 + 16 * mi + fr) * 68 + 4 * ks + fq], Tm[(4 * ks + fq) * 68 + 16 * ni + fr], acc, 0, 0, 0);
#pragma unroll
                for (int j = 0; j < 4; ++j) M1[(16 * mi + 4 * fq + j) * 36 + 16 * ni + fr] = acc[j]; }
            __syncthreads();
            if (wid < 4) { f32x4 acc = {0.f, 0.f, 0.f, 0.f};
#pragma unroll
                for (int ks = 0; ks < 8; ++ks) acc = __builtin_amdgcn_mfma_f32_16x16x4f32(Tm[(32 + 16 * mi + fr) * 68 + 32 + 4 * ks + fq], M1[(4 * ks + fq) * 36 + 16 * ni + fr], acc, 0, 0, 0);
#pragma unroll
                for (int j = 0; j < 4; ++j) Tm[(32 + 16 * mi + 4 * fq + j) * 68 + 16 * ni + fr] = -acc[j]; }
            __syncthreads();
        }
        { const int row = tid >> 3, c8 = (tid & 7) * 8; const float4 a = *(const float4*)(Tm + row * 68 + c8), bq = *(const float4*)(Tm + row * 68 + c8 + 4);
            uint4 o; o.x = pk2(a.x, a.y); o.y = pk2(a.z, a.w); o.z = pk2(bq.x, bq.y); o.w = pk2(bq.z, bq.w); *(uint4*)(Tb + row * 72 + c8) = o; }
        __syncthreads();
        if (REC_MASK & 32) { for (int i = tid; i < 64 * 72 / 8; i += 512) *(uint4*)(rec + 49152 + i * 16) = *(const uint4*)(Tb + i * 8); }
        if (REC_MASK & 64) { for (int i = tid; i < 1024; i += 512) *(uint4*)(rec + i * 16) = *(const uint4*)(vbT + i * 8); }
        if (REC_MASK & 128) { for (int i = tid; i < 1024; i += 512) *(uint4*)(rec + i * 16) = *(const uint4*)((const unsigned char*)Am + i * 16); }
        for (int rE = 0; rE < 1 + ((BLK_RPT >> 4) & 1) * 4; ++rE) if (wid < 4) {
            const int mt = wid; bf16x8 af[2];
#pragma unroll
            for (int kk = 0; kk < 2; ++kk) af[kk] = *(const bf16x8*)(Tb + (16 * mt + fr) * 72 + 32 * kk + 8 * fq);
#pragma unroll
            for (int nt = 0; nt < 8; ++nt) { f32x4 acc = {0.f, 0.f, 0.f, 0.f};
#pragma unroll
                for (int kk = 0; kk < 2; ++kk) { const bf16x8 bb = *(const bf16x8*)(vbT + (16 * nt + fr) * 72 + 32 * kk + 8 * fq); acc = mfma16(af[kk], bb, acc); }
                if (REC_MASK & 8) *(uint2*)(rec + 49152 + ((16 * nt + fr) * 64 + 16 * mt + 4 * fq) * 2) = make_uint2(pk2(acc[0], acc[1]), pk2(acc[2], acc[3])); }
        } else {
#pragma unroll
            for (int mi = 0; mi < 2; ++mi) { const int mt = (wid - 4) * 2 + mi; bf16x8 af[2];
#pragma unroll
                for (int kk = 0; kk < 2; ++kk) af[kk] = *(const bf16x8*)(kbgT + (16 * mt + fr) * 72 + 32 * kk + 8 * fq);
#pragma unroll
                for (int nt = 0; nt < 4; ++nt) { f32x4 acc = {0.f, 0.f, 0.f, 0.f};
#pragma unroll
                    for (int kk = 0; kk < 2; ++kk) { const bf16x8 bb = *(const bf16x8*)(Tb + (16 * nt + fr) * 72 + 32 * kk + 8 * fq); acc = mfma16(af[kk], bb, acc); }
                    if (REC_MASK & 16) *(uint2*)(rec + ((16 * nt + fr) * 128 + 16 * mt + 4 * fq) * 2) = make_uint2(pk2(acc[0], acc[1]), pk2(acc[2], acc[3])); } }
        }
        __syncthreads();
    }
    {
        int tid_s = threadIdx.x; asm volatile("" : "+v"(tid_s)); const int tid = tid_s, lane = tid & 63, wid = tid >> 6;
        float* qs = (float*)smem; float* ks = qs + 1024; float* vs = ks + 1024; float* red = vs + 1024; float* red2 = red + 512; float* nrm = red2 + 512;
        bf16_t* osb = (bf16_t*)(p.ws + WS_OS); float* ssq8 = (float*)(p.ws + WS_SSQ);
        const int us = tid >> 8, lt = tid & 255, v = lt & 127, kq = lt >> 7, t2 = lt >> 7, ch = lt & 127;
        for (int pu = blockIdx.x; pu < ((parts & 2) ? DB * NH / 2 : 0); pu += gridDim.x) {
            const int unit = 2 * pu + us, b = unit >> 3, h = unit & 7;
            float s[64]; float g4[4], b4[4];
            {
                const float* sd = p.st_delta + ((size_t)(b * 8 + h) * 128 + kq * 64) * 128 + v;
#pragma unroll
                for (int i = 0; i < 64; ++i) s[i] = __builtin_nontemporal_load(sd + (size_t)i * 128);
#pragma unroll
                for (int tk = 0; tk < 4; ++tk) { g4[tk] = gbuf[(size_t)(MPROWS + b * 4 + tk) * 8 + h]; b4[tk] = betab[(size_t)(MPROWS + b * 4 + tk) * 8 + h]; }
            }
            float yv[2][3];
#pragma unroll
            for (int tt2 = 0; tt2 < 2; ++tt2) { const int t = t2 + 2 * tt2;
#pragma unroll
                for (int sc = 0; sc < 3; ++sc) { const int col = sc * 1024 + h * 128 + ch; float y = 0.f;
#pragma unroll
                    for (int j = 0; j < 4; ++j) { const int tt = t - 3 + j;
                        const float xa = p.st_conv_qkv[((size_t)b * 3 + (tt < 0 ? tt + 3 : 0)) * QKVD + col], xb_ = bf2f(qkv[(size_t)(MPROWS + b * 4 + (tt < 0 ? 0 : tt)) * QKVD + col]);
                        y += p.conv_qkv_w[j * QKVD + col] * (tt < 0 ? xa : xb_); }
                    yv[tt2][sc] = silu(y); } }
#pragma unroll
            for (int tt2 = 0; tt2 < 2; ++tt2)
#pragma unroll
                for (int sc = 0; sc < 2; ++sc) { float q = yv[tt2][sc] * yv[tt2][sc];
#pragma unroll
                    for (int m = 32; m >= 1; m >>= 1) q += __shfl_xor(q, m);
                    if (lane == 0) nrm[((us * 2 + sc) * 4 + (t2 + 2 * tt2)) * 2 + (wid & 1)] = q; }
            __syncthreads();
#pragma unroll
            for (int tt2 = 0; tt2 < 2; ++tt2) { const int t = t2 + 2 * tt2;
                const float nq = nrm[((us * 2 + 0) * 4 + t) * 2] + nrm[((us * 2 + 0) * 4 + t) * 2 + 1], nk = nrm[((us * 2 + 1) * 4 + t) * 2] + nrm[((us * 2 + 1) * 4 + t) * 2 + 1];
                qs[(us * 4 + t) * 128 + ch] = yv[tt2][0] * rsqrtf(nq + EPSF) * 0.08838834764831845f; ks[(us * 4 + t) * 128 + ch] = yv[tt2][1] * rsqrtf(nk + EPSF); vs[(us * 4 + t) * 128 + ch] = yv[tt2][2]; }
            __syncthreads();
#pragma unroll
            for (int tk = 0; tk < 4; ++tk) {
                const int row = MPROWS + b * 4 + tk;
                const float eg = __expf(g4[tk]), bt = b4[tk];
                const float* kr = ks + (us * 4 + tk) * 128 + kq * 64; const float* qr = qs + (us * 4 + tk) * 128 + kq * 64;
                float pa = 0.f;
#pragma unroll
                for (int i = 0; i < 64; ++i) pa += kr[i] * s[i];
                red[(us * 2 + kq) * 128 + v] = pa;
                __syncthreads();
                const float kv = eg * (red[(us * 2) * 128 + v] + red[(us * 2 + 1) * 128 + v]);
                const float vn = bt * (vs[(us * 4 + tk) * 128 + v] - kv);
                float po = 0.f;
#pragma unroll
                for (int i = 0; i < 64; ++i) { s[i] = eg * s[i] + kr[i] * vn; po += qr[i] * s[i]; }
                red2[(us * 2 + kq) * 128 + v] = po;
                __syncthreads();
                if (lt < 128) { const float o = red2[(us * 2) * 128 + v] + red2[(us * 2 + 1) * 128 + v];
                    osb[(size_t)(row - MPROWS) * 1024 + h * 128 + v] = (bf16_t)(pk2(o, 0.f) & 0xffffu);
                    float q = o * o;
#pragma unroll
                    for (int m = 32; m >= 1; m >>= 1) q += __shfl_xor(q, m);
                    if (lane == 0) ssq8[(size_t)row * 64 + h * 8 + (wid & 1)] = q;
                } else if (lt < 134) ssq8[(size_t)row * 64 + h * 8 + 2 + (lt - 128)] = 0.f;
            }
            float* so = p.out + O_DSM + ((size_t)(b * 8 + h) * 128 + kq * 64) * 128 + v;
#pragma unroll
            for (int i = 0; i < 64; ++i) __builtin_nontemporal_store(s[i], so + (size_t)i * 128);
            __syncthreads();
        }
    }
    int tid_c = threadIdx.x; asm volatile("" : "+v"(tid_c));
    for (int idx = blockIdx.x * 512 + tid_c; idx < (NB + DB) * 3 * (QKVD / 8); idx += gridDim.x * 512) {
        const int c8 = idx % (QKVD / 8), rr = (idx / (QKVD / 8)) % 3, bb = idx / (3 * (QKVD / 8));
        const bf16_t* src; float* dst;
        if (bb < NB) { src = qkv + (size_t)(bb * TP + TP - 3 + rr) * QKVD + c8 * 8; dst = p.out + O_CQP + ((size_t)bb * 3 + rr) * QKVD + c8 * 8; }
        else { const int b2 = bb - NB; src = qkv + (size_t)(MPROWS + b2 * 4 + 1 + rr) * QKVD + c8 * 8; dst = p.out + O_CQS + ((size_t)b2 * 3 + rr) * QKVD + c8 * 8; }
        float f[8]; unpack8(*(const uint4*)src, f);
        *(float4*)dst = make_float4(f[0], f[1], f[2], f[3]); *(float4*)(dst + 4) = make_float4(f[4], f[5], f[6], f[7]);
    }
}

struct ScanOps { bf16x8 f[10]; uint2 u2[2]; float eg; };
__device__ __forceinline__ void scan_load(ScanOps& o, const P& p, const int ci, const bool roleA, const int wq, const int vs, const int fr, const int fq) {
    const unsigned char* rec = chunk_rec(p, ci);
    if (roleA) { const int mt = wq;
#pragma unroll
        for (int kk = 0; kk < 4; ++kk) { o.f[kk] = *(const bf16x8*)(rec + ((16 * mt + fr) * 128 + 32 * kk + 8 * fq) * 2); o.f[4 + kk] = *(const bf16x8*)(rec + 16384 + ((16 * mt + fr) * 128 + 32 * kk + 8 * fq) * 2); }
#pragma unroll
        for (int kk = 0; kk < 2; ++kk) o.f[8 + kk] = *(const bf16x8*)(rec + 65536 + ((16 * mt + fr) * 64 + 32 * kk + 8 * fq) * 2);
#pragma unroll
        for (int nt = 0; nt < 2; ++nt) o.u2[nt] = *(const uint2*)(rec + 49152 + ((vs * 32 + 16 * nt + fr) * 64 + 16 * mt + 4 * fq) * 2);
    } else { const int kt0 = 2 * wq;
#pragma unroll
        for (int i = 0; i < 2; ++i)
#pragma unroll
            for (int kk = 0; kk < 2; ++kk) o.f[2 * i + kk] = *(const bf16x8*)(rec + 32768 + ((16 * (kt0 + i) + fr) * 64 + 32 * kk + 8 * fq) * 2);
        o.eg = ((const float*)(p.ws + WS_EG))[ci];
    }
}

__device__ __forceinline__ void phase3(const P& p, unsigned char* smem) {
    int tid_3 = threadIdx.x; asm volatile("" : "+v"(tid_3));
    const int tid = tid_3, lane = tid & 63, wid = tid >> 6, fr = lane & 15, fq = lane >> 4;
    bf16_t* sT = (bf16_t*)smem;
    bf16_t* vnT = sT + 32 * 136;
    bf16_t* Y = (bf16_t*)(p.ws + WS_YB); float* ssq8 = (float*)(p.ws + WS_SSQ);
    const bool roleA = wid < 4; const int wq = wid & 3;
    for (int idx = blockIdx.x * 512 + tid; idx < DB * DS * 128; idx += gridDim.x * 512) { const int r = idx >> 7, c8 = (idx & 127) * 8;
        *(uint4*)(Y + (size_t)(MPROWS + r) * 1024 + c8) = *(const uint4*)((const bf16_t*)(p.ws + WS_OS) + (size_t)r * 1024 + c8); }
    bf16_t* oS = vnT + 32 * 72;
    for (int unit = blockIdx.x; unit < NB * NH * 4; unit += gridDim.x) {
        const int xcd_ = unit & 7, slot_ = unit >> 3; const int bh = xcd_ * 8 + (slot_ >> 2), vs = slot_ & 3, b = bh >> 3, h = bh & 7;
        { int tz = tid; asm volatile("" : "+v"(tz)); for (int i = tz; i < 32 * 136 / 2; i += 512) ((unsigned*)sT)[i] = 0u; }
        f32x4 S[2][2];
#pragma unroll
        for (int i = 0; i < 2; ++i)
#pragma unroll
            for (int nt = 0; nt < 2; ++nt) S[i][nt] = (f32x4){0.f, 0.f, 0.f, 0.f};
        ScanOps ops[4];
#pragma unroll
        for (int c = 0; c < 3; ++c) scan_load(ops[c], p, bh * NCPS + c, roleA, wq, vs, fr, fq);
        __syncthreads();
        auto step = [&](const ScanOps& cur, const int c) __attribute__((always_inline)) {
            const int t0 = c == 0 ? 0 : NMETA + 64 * (c - 1), L = c == 0 ? NMETA : 64; const int rb = b * TP + t0;
            f32x4 Q[2];
            if (roleA) { const int mt = wq;
#pragma unroll
                for (int nt = 0; nt < 2; ++nt) { f32x4 Pv = {0.f, 0.f, 0.f, 0.f}; Q[nt] = (f32x4){0.f, 0.f, 0.f, 0.f};
#pragma unroll
                    for (int kk = 0; kk < 4; ++kk) { const bf16x8 bs = *(const bf16x8*)(sT + (16 * nt + fr) * 136 + 32 * kk + 8 * fq); Pv = mfma16(cur.f[kk], bs, Pv); Q[nt] = mfma16(cur.f[4 + kk], bs, Q[nt]); }
                    const uint2 uu = cur.u2[nt]; const float u0 = bf2f(uu.x & 0xffffu), u1 = bf2f(uu.x >> 16), u2 = bf2f(uu.y & 0xffffu), u3 = bf2f(uu.y >> 16);
                    *(uint2*)(vnT + (16 * nt + fr) * 72 + 16 * mt + 4 * fq) = make_uint2(pk2(u0 - Pv[0], u1 - Pv[1]), pk2(u2 - Pv[2], u3 - Pv[3])); }
            }
            __syncthreads();
            if (roleA) { const int mt = wq;
#pragma unroll
                for (int nt = 0; nt < 2; ++nt) {
#pragma unroll
                    for (int kk = 0; kk < 2; ++kk) { const bf16x8 bv = *(const bf16x8*)(vnT + (16 * nt + fr) * 72 + 32 * kk + 8 * fq); Q[nt] = mfma16(cur.f[8 + kk], bv, Q[nt]); }
#pragma unroll
                    for (int jj = 0; jj < 4; ++jj) oS[(16 * mt + 4 * fq + jj) * 40 + 16 * nt + fr] = (bf16_t)(pk2(Q[nt][jj], 0.f) & 0xffffu); }
            } else { const int kt0 = 2 * wq;
#pragma unroll
                for (int nt = 0; nt < 2; ++nt) { bf16x8 bv[2];
#pragma unroll
                    for (int kk = 0; kk < 2; ++kk) bv[kk] = *(const bf16x8*)(vnT + (16 * nt + fr) * 72 + 32 * kk + 8 * fq);
#pragma unroll
                    for (int i = 0; i < 2; ++i) { S[i][nt] *= cur.eg;
#pragma unroll
                        for (int kk = 0; kk < 2; ++kk) S[i][nt] = mfma16(cur.f[2 * i + kk], bv[kk], S[i][nt]);
                        *(uint2*)(sT + (16 * nt + fr) * 136 + 16 * (kt0 + i) + 4 * fq) = make_uint2(pk2(S[i][nt][0], S[i][nt][1]), pk2(S[i][nt][2], S[i][nt][3])); } }
            }
            __syncthreads();
            if (tid < 256) {
                const int row = tid >> 2, pc = tid & 3; float f[8]; const uint4 v = *(const uint4*)(oS + row * 40 + pc * 8); unpack8(v, f);
                float sq = f[0] * f[0] + f[1] * f[1] + f[2] * f[2] + f[3] * f[3] + f[4] * f[4] + f[5] * f[5] + f[6] * f[6] + f[7] * f[7];
                sq += __shfl_xor(sq, 1); sq += __shfl_xor(sq, 2);
                if (row < L) { *(uint4*)(Y + (size_t)(rb + row) * 1024 + h * 128 + vs * 32 + pc * 8) = v;
                    if (pc == 0) *(float2*)(ssq8 + (size_t)(rb + row) * 64 + h * 8 + vs * 2) = make_float2(sq, 0.f); }
            }
        };
#pragma unroll
        for (int c = 0; c < NCPS; ++c) {
            if (c + 3 < NCPS) scan_load(ops[(c + 3) & 3], p, bh * NCPS + c + 3, roleA, wq, vs, fr, fq);
            step(ops[c & 3], c);
        }
        if (!roleA) { const int kt0 = 2 * wq; float* dp = p.out + O_DP + (size_t)bh * 16384;
#pragma unroll
            for (int i = 0; i < 2; ++i)
#pragma unroll
                for (int nt = 0; nt < 2; ++nt)
#pragma unroll
                    for (int jj = 0; jj < 4; ++jj) dp[(16 * (kt0 + i) + 4 * fq + jj) * 128 + vs * 32 + 16 * nt + fr] = S[i][nt][jj]; }
        __syncthreads();
    }
}

__device__ __forceinline__ void phase_conva(const P& p) {
    const bf16_t* ub = (const bf16_t*)p.out; const bf16_t* bz = (const bf16_t*)(p.ws + WS_MERGED); bf16_t* Y = (bf16_t*)(p.ws + WS_YA);
    for (int idx = blockIdx.x * 512 + threadIdx.x; idx < MREAL * 128; idx += gridDim.x * 512) {
        const int row = idx >> 7, ch = (idx & 127) * 8; int b, t; bool samp;
        if (row < MPROWS) { b = row / TP; t = row - b * TP; samp = false; } else { b = (row - MPROWS) >> 2; t = (row - MPROWS) & 3; samp = true; }
        float u0[8], u1[8], u2[8], zz[8];
        unpack8(*(const uint4*)(ub + (size_t)row * 1024 + ch), u2);
#pragma unroll
        for (int d = 1; d <= 2; ++d) { float* dst = d == 1 ? u1 : u0; const bool inseq = t - d >= 0;
            float f0[8]; unpack8(*(const uint4*)(ub + (size_t)(inseq ? row - d : row) * 1024 + ch), f0);
            const float* s = p.st_conv_a + ((size_t)(samp ? b : 0) * 2 + ((samp && !inseq) ? (2 + t - d) : 0)) * 1024 + ch; const float4 a = *(const float4*)s, c = *(const float4*)(s + 4);
            const float f1[8] = {a.x, a.y, a.z, a.w, c.x, c.y, c.z, c.w};
#pragma unroll
            for (int e = 0; e < 8; ++e) dst[e] = inseq ? f0[e] : (samp ? f1[e] : 0.f); }
        unpack8(ldnt16(bz + (size_t)row * 1024 + ch), zz);
        {
            bf16_t* Yb = (bf16_t*)(p.ws + WS_YB); const float* ssq = (const float*)(p.ws + WS_SSQ); const int head = ch >> 7;
            const float4 s0 = *(const float4*)(ssq + (size_t)row * 64 + head * 8), s1 = *(const float4*)(ssq + (size_t)row * 64 + head * 8 + 4);
            const float rstd = rsqrtf((s0.x + s0.y + s0.z + s0.w + s1.x + s1.y + s1.z + s1.w) * (1.f / 128.f) + EPSF);
            float o8[8], z8[8]; unpack8(ldnt16(Yb + (size_t)row * 1024 + ch), o8); unpack8(ldnt16(Y + (size_t)row * 1024 + ch), z8);
            const float4 g0 = *(const float4*)(p.gnorm_w + (ch & 127)), g1 = *(const float4*)(p.gnorm_w + (ch & 127) + 4);
            uint4 r; r.x = pk2(o8[0] * rstd * g0.x * z8[0], o8[1] * rstd * g0.y * z8[1]); r.y = pk2(o8[2] * rstd * g0.z * z8[2], o8[3] * rstd * g0.w * z8[3]);
            r.z = pk2(o8[4] * rstd * g1.x * z8[4], o8[5] * rstd * g1.y * z8[5]); r.w = pk2(o8[6] * rstd * g1.z * z8[6], o8[7] * rstd * g1.w * z8[7]);
            *(uint4*)(Yb + (size_t)row * 1024 + ch) = r; }
        float y[8];
#pragma unroll
        for (int e = 0; e < 8; ++e) y[e] = zz[e] * (p.conv_a_w[ch + e] * u0[e] + p.conv_a_w[1024 + ch + e] * u1[e] + p.conv_a_w[2048 + ch + e] * u2[e]);
        uint4 o; o.x = pk2(y[0], y[1]); o.y = pk2(y[2], y[3]); o.z = pk2(y[4], y[5]); o.w = pk2(y[6], y[7]);
        *(uint4*)(Y + (size_t)row * 1024 + ch) = o;
        float* cdst = nullptr;
        if (!samp && t >= TP - 2) cdst = p.out + O_CAP + ((size_t)b * 2 + (t - (TP - 2))) * 1024 + ch;
        if (samp && t >= 2) cdst = p.out + O_CAS + ((size_t)b * 2 + (t - 2)) * 1024 + ch;
        if (cdst) { *(float4*)cdst = make_float4(u2[0], u2[1], u2[2], u2[3]); *(float4*)(cdst + 4) = make_float4(u2[4], u2[5], u2[6], u2[7]); }
    }
}

__device__ __forceinline__ void phase_final(const P& p) {
    const int lane = threadIdx.x & 63, wid = threadIdx.x >> 6;
    for (int r = blockIdx.x * 8 + wid; r < NB * SEQ + DB * DS; r += gridDim.x * 8) {
        float* dst; const float* xs;
        if (r < NB * SEQ) { dst = p.out + O_YP + (size_t)r * DM; xs = p.x_prompt + (size_t)r * DM; } else { dst = p.out + O_YS + (size_t)(r - NB * SEQ) * DM; xs = p.x_sample + (size_t)(r - NB * SEQ) * DM; }
        float4 v[4]; float ssq = 0.f;
#pragma unroll
        for (int i = 0; i < 4; ++i) { const uint2 q = ldnt8((const bf16_t*)dst + i * 256 + lane * 4); v[i] = make_float4(bf2f(q.x & 0xffffu), bf2f(q.x >> 16), bf2f(q.y & 0xffffu), bf2f(q.y >> 16)); ssq += v[i].x * v[i].x + v[i].y * v[i].y + v[i].z * v[i].z + v[i].w * v[i].w; }
#pragma unroll
        for (int m = 32; m >= 1; m >>= 1) ssq += __shfl_xor(ssq, m);
        const float rs = rsqrtf(ssq * (1.f / 1024.f) + EPSF);
#pragma unroll
        for (int i = 0; i < 4; ++i) { const float4 w = *(const float4*)(p.norm_post + i * 256 + lane * 4), x_ = *(const float4*)(p.norm_post + i * 256 + lane * 4); const f32x4 xt_ = __builtin_nontemporal_load((const f32x4*)(xs + i * 256 + lane * 4)); const float4 x = make_float4(xt_[0], xt_[1], xt_[2], xt_[3]); (void)x_;
            stnt16f(dst + i * 256 + lane * 4, x.x + v[i].x * rs * w.x, x.y + v[i].y * rs * w.y, x.z + v[i].z * rs * w.z, x.w + v[i].w * rs * w.w); }
    }
}

#ifndef PH_MASK
#define PH_MASK 0x3ff
#endif
#define XB_TMO      128
#define XB_XCNT(j)  (256  + 64 * (j))
#define XB_XSUB(j)  (1280 + 64 * (j))
#define XB_XGEN(j)  (2304 + 64 * (j))
#define XB_TOP      3328
#define XB_TOPGEN   3392
#define XCD_BAR_WORDS 3456
#define XB_SPIN_CAP (1u << 18)
#define LAS __attribute__((address_space(3)))

__device__ __forceinline__ unsigned xb_ld(unsigned* p)              { return __hip_atomic_load(p, __ATOMIC_RELAXED, __HIP_MEMORY_SCOPE_AGENT); }
__device__ __forceinline__ unsigned xb_add(unsigned* p, unsigned v) { return __hip_atomic_fetch_add(p, v, __ATOMIC_RELAXED, __HIP_MEMORY_SCOPE_AGENT); }
__device__ __forceinline__ unsigned xb_xcc_id() { return (unsigned)__builtin_amdgcn_s_getreg((3 << 11) | 20) & 0xFu; }
#define XB_SPIN(cond, bar) do { unsigned _sp = 0; while (cond) { __builtin_amdgcn_s_sleep(1); \
    if ((++_sp & 255u) == 0u) { if (xb_ld(&(bar)[XB_TMO])) break; if (_sp > XB_SPIN_CAP) { atomicAdd(&(bar)[XB_TMO], 1u); break; } } } } while (0)

struct XcdBarrier {
    unsigned* bar; unsigned x;
    volatile LAS unsigned* st;
};

__device__ __forceinline__ XcdBarrier xcd_barrier_post(unsigned* bar, volatile LAS unsigned* st) {
    XcdBarrier b; b.bar = bar; b.x = xb_xcc_id(); b.st = st;
    if (threadIdx.x == 0) (void)xb_add(&bar[XB_XCNT(b.x)], 1u);
    return b;
}
__device__ __forceinline__ void xcd_barrier_complete(unsigned* bar, unsigned x, unsigned& nloc, unsigned& nx) {
    const unsigned G = gridDim.x * gridDim.y * gridDim.z;
    unsigned sum, cnt, mine, sp = 0u;
    for (;;) {
        sum = 0u; cnt = 0u; mine = 0u;
#pragma unroll
        for (unsigned j = 0; j < 16; ++j) { const unsigned c = xb_ld(&bar[XB_XCNT(j)]); sum += c; cnt += (c > 0u) ? 1u : 0u; mine = (j == x) ? c : mine; }
        if (sum == G) break;
        __builtin_amdgcn_s_sleep(1);
        if ((++sp & 255u) == 0u) { if (xb_ld(&bar[XB_TMO])) break; if (sp > XB_SPIN_CAP) { atomicAdd(&bar[XB_TMO], 1u); break; } }
    }
    nloc = mine > 0u ? mine : 1u; nx = cnt > 0u ? cnt : 1u;
}

__device__ __forceinline__ void xcd_barrier(const XcdBarrier& b) {
    asm volatile("s_waitcnt vmcnt(0)" ::: "memory");
    __syncthreads();
    if (threadIdx.x == 0) {
        unsigned* bar = b.bar;
        __builtin_amdgcn_s_waitcnt(0);
        unsigned nloc = b.st[0], nx = b.st[1];
        if (nloc == 0u) { xcd_barrier_complete(bar, b.x, nloc, nx); b.st[0] = nloc; b.st[1] = nx; }
        const unsigned old = xb_add(&bar[XB_XSUB(b.x)], 1u);
        const unsigned gen = old / nloc;
        if (old + 1u == (gen + 1u) * nloc) {
            __builtin_amdgcn_fence(__ATOMIC_RELEASE, "agent");
            asm volatile("s_waitcnt vmcnt(0)" ::: "memory");
            const unsigned og = xb_add(&bar[XB_TOP], 1u);
            const unsigned tg = og / nx;
            if (og + 1u == (tg + 1u) * nx) xb_add(&bar[XB_TOPGEN], 1u);
            else XB_SPIN(xb_ld(&bar[XB_TOPGEN]) == tg, bar);
            __builtin_amdgcn_fence(__ATOMIC_ACQUIRE, "agent");
            xb_add(&bar[XB_XGEN(b.x)], 1u);
            asm volatile("s_waitcnt vmcnt(0)" ::: "memory");
        } else {
            XB_SPIN(xb_ld(&bar[XB_XGEN(b.x)]) == gen, bar);
            __builtin_amdgcn_fence(__ATOMIC_ACQUIRE, "agent");
            asm volatile("s_waitcnt vmcnt(0)" ::: "memory");
        }
    }
    __syncthreads();
}


__global__ __launch_bounds__(512, 2) void hybrid_fwd(P p_arg) {
    extern __shared__ __attribute__((aligned(16))) unsigned char smem[];
    const P& p = *(const P*)(const __attribute__((address_space(4))) P*)__builtin_amdgcn_kernarg_segment_ptr();
    PG8_LAS unsigned char* lds = (PG8_LAS unsigned char*)smem;
    unsigned* bar = (unsigned*)(p.ws + WS_BAR);
    volatile LAS unsigned* xbst = (volatile LAS unsigned*)(lds + 139264);
    if (threadIdx.x == 0) { xbst[0] = 0u; xbst[1] = 0u; }
    __syncthreads();
    const XcdBarrier xb = xcd_barrier_post(bar, xbst);
    const bf16_t* xn = (const bf16_t*)(p.ws + WS_XN); const bf16_t* wtin = (const bf16_t*)(p.ws + WS_WTIN);
#if (PH_MASK >> 0) & 1
    for (int rpt_ = 0; rpt_ < 1 + ((RPT_MASK >> 0) & 1); ++rpt_) {
    phase0(p, smem);
    }
#endif
    xcd_barrier(xb);
#if (PH_MASK >> 1) & 1
    for (int rpt_ = 0; rpt_ < 1 + ((RPT_MASK >> 1) & 1); ++rpt_) {
    { StaticOrder S; S.init(MPAD, 3328, (int)gridDim.x, (int)blockIdx.x); EpiIn E; E.dry = 0; E.mode = 0; E.pp = &p; pg8::gemm_phase<EpiIn, StaticOrder, false>(lds, Gemm{xn, wtin, MPAD, 3328, 1024}, S, E, nullptr); }
    }
#endif
    xcd_barrier(xb);
#if (PH_MASK >> 2) & 1
    for (int rpt_ = 0; rpt_ < 1 + ((RPT_MASK >> 2) & 1); ++rpt_) {
    phase2(p, smem, rpt_ == 0 ? 3 : RPT_P2);
    }
#endif
#ifdef DBG_DUMP
    { const uint4* src = (const uint4*)(p.ws + WS_QKV); uint4* dst = (uint4*)p.out; for (size_t i = (size_t)blockIdx.x * 512 + threadIdx.x; i < (size_t)6000000; i += (size_t)gridDim.x * 512) dst[i] = src[i];
      const uint4* s2 = (const uint4*)(p.ws + WS_BETA); for (size_t i = (size_t)blockIdx.x * 512 + threadIdx.x; i < (size_t)68000; i += (size_t)gridDim.x * 512) dst[6000000 + i] = s2[i]; }
#endif
    xcd_barrier(xb);
#if (PH_MASK >> 3) & 1
    for (int rpt_ = 0; rpt_ < 1 + ((RPT_MASK >> 3) & 1); ++rpt_) {
    phase3(p, smem);
    }
#endif
    xcd_barrier(xb);
#if (PH_MASK >> 4) & 1
    for (int rpt_ = 0; rpt_ < 1 + ((RPT_MASK >> 4) & 1); ++rpt_) {
    { StaticOrder S; S.init(MPAD, 7168, (int)gridDim.x, (int)blockIdx.x); EpiIn E; E.dry = (rpt_ == 0 && ((RPT_MASK >> 4) & 1)) ? 1 : 0; E.mode = 1; E.pp = &p; pg8::gemm_phase<EpiIn, StaticOrder, false>(lds, Gemm{xn, wtin + (size_t)3328 * 1024, MPAD, 7168, 1024}, S, E, nullptr); }
    }
#endif
    xcd_barrier(xb);
#if (PH_MASK >> 5) & 1
    for (int rpt_ = 0; rpt_ < 1 + ((RPT_MASK >> 5) & 1); ++rpt_) {
    phase_conva(p);
    }
#endif
    xcd_barrier(xb);
#if (PH_MASK >> 7) & 1
    for (int rpt_ = 0; rpt_ < 1 + ((RPT_MASK >> 7) & 1); ++rpt_) {
    { MergeOrder S; S.init(MPAD, 1024, (int)gridDim.x, (int)blockIdx.x); S.pass = 0; EpiMerge E; E.pp = &p; E.pass = 0; pg8::gemm_phase<EpiMerge, MergeOrder, false>(lds, Gemm{(const bf16_t*)(p.ws + WS_YA), (const bf16_t*)(p.ws + WS_WTA), MPAD, 1024, 1024}, S, E, nullptr);
      S.pass = 1; E.pass = 1; pg8::gemm_phase<EpiMerge, MergeOrder, false>(lds, Gemm{(const bf16_t*)(p.ws + WS_YB), (const bf16_t*)(p.ws + WS_WTB), MPAD, 1024, 1024}, S, E, nullptr); }
    }
#endif
    xcd_barrier(xb);
#if (PH_MASK >> 8) & 1
    for (int rpt_ = 0; rpt_ < 1 + ((RPT_MASK >> 8) & 1); ++rpt_) {
    { StaticOrder S; S.init(MPAD, 1024, (int)gridDim.x, (int)blockIdx.x); EpiPre E; E.pp = &p; pg8::gemm_phase<EpiPre, StaticOrder, false>(lds, Gemm{(const bf16_t*)(p.ws + WS_MERGED), (const bf16_t*)(p.ws + WS_WTO), MPAD, 1024, 1024}, S, E, nullptr); }
    }
#endif
    xcd_barrier(xb);
#if (PH_MASK >> 9) & 1
    for (int rpt_ = 0; rpt_ < 1 + ((RPT_MASK >> 9) & 1); ++rpt_) {
    phase_final(p);
    }
#endif
#ifdef XBAR
    for (unsigned k = 0; k < XBAR; ++k) xcd_barrier(xb);
#endif
}

extern "C" void kernel_launch(void* const* d_in, const int* in_sizes, int n_in, void* d_out, int out_size, void* d_ws, size_t ws_size, hipStream_t stream) {
    static int grid_blocks = 0;
    if (!grid_blocks) {
        int dev = 0, cus = 0, per_cu = 0;
        hipGetDevice(&dev);
        hipDeviceGetAttribute(&cus, hipDeviceAttributeMultiprocessorCount, dev);
        hipFuncSetAttribute((const void*)hybrid_fwd, hipFuncAttributeMaxDynamicSharedMemorySize, LDS_BYTES);
        hipOccupancyMaxActiveBlocksPerMultiprocessor(&per_cu, (const void*)hybrid_fwd, 512, LDS_BYTES);
        if (per_cu < 1) per_cu = 1;
        grid_blocks = cus * per_cu;
        if (ws_size < (size_t)268435456) fprintf(stderr, "kernel_launch: workspace %zu smaller than the 256 MiB this kernel maps\n", ws_size);
    }
    P p{};
    const float* const* in = (const float* const*)d_in;
    p.x_prompt = in[0]; p.x_sample = in[1]; p.st_conv_a = in[2]; p.st_conv_qkv = in[3]; p.st_delta = in[4]; p.meta = in[5]; p.norm_pre = in[6]; p.norm_post = in[7];
    p.w_in = in[8]; p.b_gate = in[9]; p.conv_a_w = in[10]; p.conv_qkv_w = in[11]; p.a_log = in[12]; p.dt_bias = in[13]; p.gnorm_w = in[14]; p.w_a_out = in[15]; p.w_b_out = in[16]; p.w_o = in[17];
    p.out = (float*)d_out; p.ws = (unsigned char*)d_ws;
    hipMemsetAsync((char*)d_ws + WS_BAR, 0, XCD_BAR_WORDS * 4 + 256, stream);
    void* args[] = {&p};
    hipError_t e = hipLaunchCooperativeKernel((const void*)hybrid_fwd, dim3(grid_blocks), dim3(512), args, LDS_BYTES, stream);
    if (e != hipSuccess) fprintf(stderr, "cooperative launch failed: %s (grid %d)\n", hipGetErrorString(e), grid_blocks);
}
```

```cpp
#define REC_MASK 31
#ifndef RPT_MASK
#define RPT_MASK 0
#endif
#define RPT_P2 3
#ifndef BLK_RPT
#define BLK_RPT 0
#endif
#include <hip/hip_runtime.h>
#include <hip/hip_cooperative_groups.h>
#include <cstdio>
namespace cg = cooperative_groups;


namespace pg8 {
#define PG8_LAS __attribute__((address_space(3)))
typedef unsigned short bf16_t;
typedef short bf16x8 __attribute__((ext_vector_type(8)));
typedef float f32x4 __attribute__((ext_vector_type(4)));
typedef unsigned u32x4 __attribute__((ext_vector_type(4)));
constexpr int BM = 256, BK = 64, HALF = 128, HTB = HALF * BK * 2  , STAGE_BYTES = 8 * HTB, NXCD = 8, WGM = 4;

__host__ __device__ __forceinline__ int lds_byte(int r, int c) { const int st = (r >> 4) * 2 + (c >> 5), rr = r & 15, cc = c & 31, ob = rr * 64 + cc * 2; return st * 1024 + (ob ^ (((ob >> 9) & 1) << 5)); }
__host__ __device__ __forceinline__ void stage_rc(int b, int& R, int& C) { const int st = b / 1024, sb = b % 1024, swz = sb ^ (((sb >> 9) & 1) << 5); R = (st >> 1) * 16 + swz / 64; C = (st & 1) * 32 + (swz % 64) / 2; }
__host__ __device__ __forceinline__ int perm32(int rho) { const int n = rho >> 4, i = rho & 15; return 8 * (i >> 2) + 4 * n + (i & 3); }


struct Unit { int pm, pn, tag; };
struct Gemm { const bf16_t* A; const bf16_t* Bt; int M, N, K; };

struct StaticOrder {
    int nM, nN, nwg, G, c;
    __host__ __device__ void init(int M, int N, int G_, int c_) { nM = M / BM; nN = N / BM; nwg = nM * nN; G = G_; c = c_; }
    __host__ __device__ bool next(int i, Unit& u) const {
        const long L = (long)i * G + c; if (L >= nwg) return false;
        int wgid = (int)L; { const int q = nwg / NXCD, r = nwg % NXCD, xcd = wgid % NXCD, off = wgid / NXCD; wgid = (xcd < r ? xcd * (q + 1) : r * (q + 1) + (xcd - r) * q) + off; }
        const int nig = WGM * nN, gid = wgid / nig, fm = gid * WGM, gsz = (nM - fm) < WGM ? (nM - fm) : WGM;
        u.pm = fm + ((wgid % nig) % gsz); u.pn = (wgid % nig) / gsz; return true;
    }
    __device__ __forceinline__ void a_ready(const Unit&) const {}
    __device__ __forceinline__ void done(const Unit&) const {}
};

__device__ __forceinline__ unsigned cvt_pk_bf16(float lo, float hi) { unsigned r; asm volatile("v_cvt_pk_bf16_f32 %0, %1, %2" : "=v"(r) : "v"(lo), "v"(hi)); return r; }

template <class Epi, class Sched, bool STAMP = false>
__device__ __forceinline__ void gemm_phase(PG8_LAS unsigned char* lds, const Gemm g, const Sched& S, const Epi& E, unsigned long long* stamps) {
    int tid_ = threadIdx.x; asm volatile("" : "+v"(tid_));
    const int tid = tid_, wid = __builtin_amdgcn_readfirstlane(tid >> 6), lane = tid & 63, wr = wid >> 2, wc = wid & 3, fr = lane & 15, fq = lane >> 4;
    const int K = g.K, nt = K / BK;
    int ts_lo = 0, ts_hi = 0, nts = 0; const unsigned long long rt_entry = STAMP ? (unsigned long long)wall_clock64() : 0ull;
#define PG8_STAMP() do { if (STAMP && wid == 0 && nts < 64) { const unsigned long long _c = (unsigned long long)clock64(); \
        ts_lo = (lane == nts) ? (int)(unsigned)_c : ts_lo; ts_hi = (lane == nts) ? (int)(unsigned)(_c >> 32) : ts_hi; ++nts; } } while (0)
    PG8_STAMP();
    unsigned voffA[2], voffB[2];
#pragma unroll
    for (int i = 0; i < 2; ++i) { int R, C; stage_rc(tid * 16 + i * 8192, R, C); const int Rb = Epi::PERM ? ((R & ~31) + perm32(R & 31)) : R;
        voffA[i] = (unsigned)(R * K + C) * 2u; voffB[i] = (unsigned)(Rb * K + C) * 2u; }
    const size_t kstep = (size_t)(BK * 2);
    const size_t hstep = (size_t)HALF * K * 2;
    const size_t tstep = 2 * hstep;
    const unsigned ldsw = (unsigned)wid * 1024u;
    const int aoff = lds_byte(wr * 64 + fr, fq * 8), boff = lds_byte(wc * 32 + fr, fq * 8);
#define PG8_SA(b, h) (((b) * 2 + (h)) * HTB)
#define PG8_SB(b, h) ((4 + (b) * 2 + (h)) * HTB)
#define PG8_STAGE(bufoff, gbase, voff) do { _Pragma("unroll") for (int _i = 0; _i < 2; ++_i) \
        __builtin_amdgcn_global_load_lds((const unsigned*)((const char*)(gbase) + (voff)[_i]), (PG8_LAS unsigned*)(lds + (bufoff) + ldsw + _i * 8192), 16, 0, 0); } while (0)
#define PG8_LDA(dst, b, h) do { _Pragma("unroll") for (int m = 0; m < 4; ++m) _Pragma("unroll") for (int k = 0; k < 2; ++k) dst[m][k] = *(const PG8_LAS bf16x8*)(lds + PG8_SA(b, h) + aoff + m * 2048 + k * 1024); } while (0)
#define PG8_LDB(dst, b, h) do { _Pragma("unroll") for (int n = 0; n < 2; ++n) _Pragma("unroll") for (int k = 0; k < 2; ++k) dst[n][k] = *(const PG8_LAS bf16x8*)(lds + PG8_SB(b, h) + boff + n * 2048 + k * 1024); } while (0)
#define PG8_MMA(ai, bj, At, Bt) do { __builtin_amdgcn_s_setprio(1); _Pragma("unroll") for (int m = 0; m < 4; ++m) _Pragma("unroll") for (int n = 0; n < 2; ++n) _Pragma("unroll") for (int k = 0; k < 2; ++k) \
        acc[ai][bj][m][n] = __builtin_amdgcn_mfma_f32_16x16x32_bf16(Bt[n][k], At[m][k], acc[ai][bj][m][n], 0, 0, 0); __builtin_amdgcn_s_setprio(0); } while (0)
#define PG8_WAIT_V(n) asm volatile("s_waitcnt vmcnt(" #n ")" ::: "memory")
#define PG8_WAIT_L(n) asm volatile("s_waitcnt lgkmcnt(" #n ")" ::: "memory")
#define PG8_BAR __builtin_amdgcn_s_barrier()
#define PG8_SCHED __builtin_amdgcn_sched_barrier(0)
    Unit cur, nxt; int ui = 0;
    if (!S.next(0, cur)) return;
    f32x4 acc[2][2][4][2];
#pragma unroll
    for (int a = 0; a < 2; ++a)
#pragma unroll
        for (int b = 0; b < 2; ++b)
#pragma unroll
            for (int m = 0; m < 4; ++m)
#pragma unroll
                for (int n = 0; n < 2; ++n) acc[a][b][m][n] = (f32x4){0.f, 0.f, 0.f, 0.f};
    bf16x8 At[4][2], B0[2][2], B1[2][2];
    const char* cA = (const char*)g.A + (size_t)cur.pm * tstep; const char* cB = (const char*)g.Bt + (size_t)cur.pn * tstep;
    S.a_ready(cur);
    PG8_STAGE(PG8_SB(0, 0), cB, voffB); PG8_STAGE(PG8_SA(0, 0), cA, voffA); PG8_STAGE(PG8_SB(0, 1), cB + hstep, voffB); PG8_STAGE(PG8_SA(0, 1), cA + hstep, voffA);
    if (wr == 1) PG8_BAR;
    PG8_WAIT_V(4); PG8_BAR;
    PG8_STAGE(PG8_SB(1, 0), cB + kstep, voffB); PG8_STAGE(PG8_SA(1, 0), cA + kstep, voffA); PG8_STAGE(PG8_SB(1, 1), cB + hstep + kstep, voffB);
    PG8_WAIT_V(6); PG8_BAR;
    PG8_STAMP();
    for (;;) {
        const bool has_next = S.next(ui + 1, nxt);
        const char* nA = has_next ? (const char*)g.A + (size_t)nxt.pm * tstep : cA; const char* nB = has_next ? (const char*)g.Bt + (size_t)nxt.pn * tstep : cB;
        for (int t = 0; t < nt; t += 2) {
            const bool last = (t == nt - 2);
            const char* a1 = cA + (size_t)(t + 1) * kstep;
            const char* a2 = last ? nA : cA + (size_t)(t + 2) * kstep; const char* b2 = last ? nB : cB + (size_t)(t + 2) * kstep;
            const char* a3 = a2 + kstep; const char* b3 = b2 + kstep;
            if (last && has_next) S.a_ready(nxt);
            if constexpr (Epi::HAS_MID) { if (t == (nt >> 1)) E.mid(acc, cur, wr, wc, fr, fq); }
            PG8_LDB(B0, 0, 0); PG8_SCHED; PG8_LDA(At, 0, 0); PG8_STAGE(PG8_SA(1, 1), a1 + hstep, voffA);
            PG8_WAIT_L(8); PG8_BAR; PG8_WAIT_L(0); PG8_MMA(0, 0, At, B0); PG8_BAR; PG8_SCHED;
            PG8_LDB(B1, 0, 1); PG8_STAGE(PG8_SB(0, 0), b2, voffB);
            PG8_BAR; PG8_WAIT_L(0); PG8_MMA(0, 1, At, B1); PG8_BAR;
            PG8_LDA(At, 0, 1); PG8_STAGE(PG8_SA(0, 0), a2, voffA);
            PG8_BAR; PG8_WAIT_L(0); PG8_MMA(1, 0, At, B0); PG8_BAR; PG8_SCHED;
            PG8_STAGE(PG8_SB(0, 1), b2 + hstep, voffB);
            PG8_WAIT_V(6); PG8_BAR; PG8_MMA(1, 1, At, B1); PG8_BAR;
            PG8_LDB(B0, 1, 0); PG8_SCHED; PG8_LDA(At, 1, 0); PG8_STAGE(PG8_SA(0, 1), a2 + hstep, voffA);
            PG8_WAIT_L(8); PG8_BAR; PG8_WAIT_L(0); PG8_MMA(0, 0, At, B0); PG8_BAR; PG8_SCHED;
            PG8_LDB(B1, 1, 1); PG8_STAGE(PG8_SB(1, 0), b3, voffB);
            PG8_BAR; PG8_WAIT_L(0); PG8_MMA(0, 1, At, B1); PG8_BAR;
            PG8_LDA(At, 1, 1); PG8_STAGE(PG8_SA(1, 0), a3, voffA);
            PG8_BAR; PG8_WAIT_L(0); PG8_MMA(1, 0, At, B0); PG8_BAR; PG8_SCHED;
            PG8_STAGE(PG8_SB(1, 1), b3 + hstep, voffB);
            PG8_WAIT_V(6); PG8_BAR; PG8_MMA(1, 1, At, B1); PG8_BAR;
        }
        PG8_STAMP();
        if constexpr (!Epi::AFTER_DRAIN) { E(acc, cur, wr, wc, fr, fq); S.done(cur); }
        PG8_STAMP();
        if (!has_next) break;
#pragma unroll
        for (int a = 0; a < 2; ++a)
#pragma unroll
            for (int b = 0; b < 2; ++b)
#pragma unroll
                for (int m = 0; m < 4; ++m)
#pragma unroll
                    for (int n = 0; n < 2; ++n) acc[a][b][m][n] = (f32x4){0.f, 0.f, 0.f, 0.f};
        cur = nxt; cA = nA; cB = nB; ++ui;
    }
    PG8_WAIT_V(0);
    if (wr == 0) PG8_BAR;
    PG8_BAR;
    if constexpr (Epi::AFTER_DRAIN) { E.fused(acc, cur, wr, wc, fr, fq, lds, wid, lane); S.done(cur); }
    PG8_STAMP();
    if (STAMP && wid == 0) { stamps[lane] = lane < nts ? (((unsigned long long)(unsigned)ts_hi << 32) | (unsigned)ts_lo) : 0ull;
        if (lane == 62) stamps[62] = rt_entry; if (lane == 63) stamps[63] = (unsigned long long)wall_clock64(); }
#undef PG8_STAMP
#undef PG8_SA
#undef PG8_SB
#undef PG8_STAGE
#undef PG8_LDA
#undef PG8_LDB
#undef PG8_MMA
#undef PG8_WAIT_V
#undef PG8_WAIT_L
#undef PG8_BAR
#undef PG8_SCHED
}
}


using pg8::bf16_t; using pg8::bf16x8; using pg8::f32x4; using pg8::Unit; using pg8::Gemm; using pg8::StaticOrder;

struct MergeOrder : StaticOrder {
    int pass;
    __device__ __forceinline__ bool next(int i, Unit& u) const {
        const int X = nwg - G; const bool special = (X > 0 && 2 * X <= G);
        long L;
        if (!special) { L = (long)i * G + c; if (L >= nwg) return false; }
        else if (i == 0) L = c;
        else if (i == 1 && pass == 0 && c < X) L = G + c;
        else if (i == 1 && pass == 1 && c >= X && c < 2 * X) L = G + (c - X);
        else return false;
        int wgid = (int)L; { const int q = nwg / pg8::NXCD, r = nwg % pg8::NXCD, xcd = wgid % pg8::NXCD, off = wgid / pg8::NXCD; wgid = (xcd < r ? xcd * (q + 1) : r * (q + 1) + (xcd - r) * q) + off; }
        const int nig = pg8::WGM * nN, gid = wgid / nig, fm = gid * pg8::WGM, gsz = (nM - fm) < pg8::WGM ? (nM - fm) : pg8::WGM;
        u.pm = fm + ((wgid % nig) % gsz); u.pn = (wgid % nig) / gsz; u.tag = (special && L >= G) ? (int)(L - G) : -1; return true;
    }
};

constexpr int DM = 1024, NB = 8, SEQ = 2048, NMETA = 16, TP = SEQ + NMETA, DB = 128, DS = 4, NH = 8;
constexpr int MPROWS = NB * TP;
constexpr int MREAL = MPROWS + DB * DS;
constexpr int MPAD = 17152;
constexpr int NIN = 10256, QKVD = 3072;
constexpr int NCPS = 33, NCHUNK = NB * NH * NCPS;
constexpr float EPSF = 1e-6f;
constexpr size_t O_YP = 0, O_YS = 16777216, O_CAP = 17301504, O_CQP = 17317888, O_DP = 17391616, O_CAS = 18440192, O_CQS = 18702336, O_DSM = 19881984;
constexpr size_t WS_WTA = 0, WS_WTB = 2097152, WS_WTO = 4194304, WS_BETA = 6291456, WS_G = 6840320, WS_SSQ = 7389184, WS_EG = 11780096, WS_OS = 11788544, WS_BAR = 12845056,
                 WS_XN = 13631488, WS_WTIN = 48758784, WS_QKV = 70254592, WS_YA = WS_QKV, WS_YB = WS_QKV + 35127296, WS_MERGED = WS_QKV + 70254592,
                 WS_CHA = 175636480, WS_UB = WS_CHA, WS_BZ = WS_CHA + 35127296, WS_GA = WS_CHA, WS_GB = WS_CHA + 35127296;
constexpr int CH_REC = 73728, CH_IN_WS = 1258;
constexpr int LDS_BYTES = 139264 + 16;

struct P {
    const float *x_prompt, *x_sample, *st_conv_a, *st_conv_qkv, *st_delta, *meta, *norm_pre, *norm_post, *w_in, *b_gate,
                *conv_a_w, *conv_qkv_w, *a_log, *dt_bias, *gnorm_w, *w_a_out, *w_b_out, *w_o;
    float* out; unsigned char* ws;
};

__device__ __forceinline__ float bf2f(unsigned b) { return __uint_as_float(b << 16); }
typedef float f32x2_t __attribute__((ext_vector_type(2)));
typedef __bf16 bf16x2_t __attribute__((ext_vector_type(2)));
__device__ __forceinline__ unsigned pk2(float lo, float hi) { const f32x2_t v = {lo, hi}; const bf16x2_t b = __builtin_convertvector(v, bf16x2_t); return __builtin_bit_cast(unsigned, b); }
__device__ __forceinline__ float sigm(float x) { return __builtin_amdgcn_rcpf(1.f + __expf(-x)); }
__device__ __forceinline__ float silu(float x) { return x * __builtin_amdgcn_rcpf(1.f + __expf(-x)); }
typedef unsigned u32x4_t __attribute__((ext_vector_type(4)));
typedef unsigned u32x2_t __attribute__((ext_vector_type(2)));
__device__ __forceinline__ uint4 ldnt16(const void* p) { const u32x4_t t = __builtin_nontemporal_load((const u32x4_t*)p); return make_uint4(t[0], t[1], t[2], t[3]); }
__device__ __forceinline__ uint2 ldnt8(const void* p) { const u32x2_t t = __builtin_nontemporal_load((const u32x2_t*)p); return make_uint2(t[0], t[1]); }
__device__ __forceinline__ void stnt16f(float* p, float a, float b, float c, float d) { const f32x4 t = {a, b, c, d}; __builtin_nontemporal_store(t, (f32x4*)p); }
__device__ __forceinline__ f32x4 mfma16(bf16x8 a, bf16x8 b, f32x4 c) { return __builtin_amdgcn_mfma_f32_16x16x32_bf16(a, b, c, 0, 0, 0); }
__device__ __forceinline__ void unpack8(uint4 v, float* f) {
    f[0] = bf2f(v.x & 0xffffu); f[1] = bf2f(v.x >> 16); f[2] = bf2f(v.y & 0xffffu); f[3] = bf2f(v.y >> 16);
    f[4] = bf2f(v.z & 0xffffu); f[5] = bf2f(v.z >> 16); f[6] = bf2f(v.w & 0xffffu); f[7] = bf2f(v.w >> 16);
}
__device__ __forceinline__ unsigned char* chunk_rec(const P& p, int ci) {
    return ci < CH_IN_WS ? p.ws + WS_CHA + (size_t)ci * CH_REC : (unsigned char*)p.out + (size_t)(ci - CH_IN_WS) * CH_REC;
}

__device__ __forceinline__ int wtin_col(int c) {
    if (c >= 3072) { if (c < 3328) return (c - 3072 < 16) ? 8192 + (c - 3072) : -1; c -= 256; }
    if (c < 4096) { const int g = c & ~31, w = c & 31, n = (w >> 4) & 1, fq = (w >> 2) & 3, j = w & 3; return 4096 + g + 8 * fq + 4 * n + j; }
    if (c < 8192) { const int rel = c - 4096, tile = rel >> 8, w = rel & 255, bj = w >> 7, wc = (w >> 5) & 3, n = (w >> 4) & 1, fq = (w >> 2) & 3, j = w & 3;
        const int type = (tile >> 3) * 2 + n, ch = 128 * (tile & 7) + 32 * wc + 8 * fq + 4 * bj + j; const int off = type == 0 ? 0 : (type == 1 ? 2048 : (type == 2 ? 1024 : 3072)); return off + ch; }
    { const int rel = c - 8192, g = rel & ~31, w = rel & 31, n = (w >> 4) & 1, fq = (w >> 2) & 3, j = w & 3; return 8208 + g + 8 * fq + 4 * n + j; }
}

__device__ __forceinline__ void phase0(const P& p, unsigned char* smem) {
    const int tid = threadIdx.x, lane = tid & 63, wid = tid >> 6;
    float* tileS = (float*)smem;
    {
        constexpr int NTILES = 1312 + 128 * 3;
        auto tparams = [&](const int tile, const float*& src, int& ld, int& n0, int& k0, int& mode, bf16_t*& dst) __attribute__((always_inline)) {
            if (tile < 1312) { mode = 0; n0 = (tile >> 3) * 64; k0 = (tile & 7) * 128; src = p.w_in; ld = NIN; dst = (bf16_t*)(p.ws + WS_WTIN); }
            else { const int t = (tile - 1312) & 127, w = (tile - 1312) >> 7; mode = 1; n0 = (t >> 3) * 64; k0 = (t & 7) * 128; src = w == 0 ? p.w_a_out : (w == 1 ? p.w_b_out : p.w_o); ld = 1024;
                dst = (bf16_t*)(p.ws + (w == 0 ? WS_WTA : (w == 1 ? WS_WTB : WS_WTO))); }
        };
        float v[16];
        auto tload = [&](const int tile) __attribute__((always_inline)) {
            const float* src; int ld, n0, k0, mode; bf16_t* dst; tparams(tile, src, ld, n0, k0, mode, dst);
            const int nn = tid & 63; const int col = mode == 0 ? wtin_col(n0 + nn) : (n0 + nn);
#pragma unroll
            for (int i = 0; i < 16; ++i) { const int kk = (tid >> 6) + 8 * i; v[i] = col >= 0 ? __builtin_nontemporal_load(src + (size_t)(k0 + kk) * ld + col) : 0.f; }
        };
        if ((int)blockIdx.x < NTILES) tload(blockIdx.x);
        int par = 0;
        for (int tile = blockIdx.x; tile < NTILES; tile += gridDim.x, par ^= 1) {
            const float* src; int ld, n0, k0, mode; bf16_t* dst; tparams(tile, src, ld, n0, k0, mode, dst);
            float* tb = tileS + par * (128 * 65);
            { const int nn = tid & 63;
#pragma unroll
              for (int i = 0; i < 16; ++i) { const int kk = (tid >> 6) + 8 * i; tb[kk * 65 + nn] = v[i]; } }
            if (tile + (int)gridDim.x < NTILES) tload(tile + gridDim.x);
            __syncthreads();
            {
                const int nn = tid >> 3, kq = tid & 7; float f[16];
#pragma unroll
                for (int j = 0; j < 16; ++j) f[j] = tb[(kq * 16 + j) * 65 + nn];
                uint4 o0, o1; o0.x = pk2(f[0], f[1]); o0.y = pk2(f[2], f[3]); o0.z = pk2(f[4], f[5]); o0.w = pk2(f[6], f[7]); o1.x = pk2(f[8], f[9]); o1.y = pk2(f[10], f[11]); o1.z = pk2(f[12], f[13]); o1.w = pk2(f[14], f[15]);
                bf16_t* d = dst + (size_t)(n0 + nn) * 1024 + k0 + kq * 16; *(uint4*)d = o0; *(uint4*)(d + 8) = o1;
            }
        }
        __syncthreads();
    }
    bf16_t* xn = (bf16_t*)(p.ws + WS_XN);
    float4 xpre[4];
    auto rowload = [&](const int r) __attribute__((always_inline)) {
        if (r < MREAL) { const float* src;
            if (r < MPROWS) { const int b = r / TP, t = r - b * TP; src = (t < NMETA) ? p.meta + (size_t)t * DM : p.x_prompt + ((size_t)b * SEQ + (t - NMETA)) * DM; }
            else src = p.x_sample + (size_t)(r - MPROWS) * DM;
#pragma unroll
            for (int i = 0; i < 4; ++i) { const f32x4 t_ = __builtin_nontemporal_load((const f32x4*)(src + i * 256 + lane * 4)); xpre[i] = make_float4(t_[0], t_[1], t_[2], t_[3]); } }
    };
    rowload(blockIdx.x * 8 + wid);
    for (int r = blockIdx.x * 8 + wid; r < MPAD; r += gridDim.x * 8) {
        if (r >= MREAL) {
#pragma unroll
            for (int i = 0; i < 4; ++i) *(uint2*)(xn + (size_t)r * 1024 + i * 256 + lane * 4) = make_uint2(0u, 0u);
            continue;
        }
        float x[16]; float ssq = 0.f;
#pragma unroll
        for (int i = 0; i < 4; ++i) { const float4 v = xpre[i]; x[i * 4 + 0] = v.x; x[i * 4 + 1] = v.y; x[i * 4 + 2] = v.z; x[i * 4 + 3] = v.w;
            ssq += v.x * v.x + v.y * v.y + v.z * v.z + v.w * v.w; }
        rowload(r + gridDim.x * 8);
#pragma unroll
        for (int m = 32; m >= 1; m >>= 1) ssq += __shfl_xor(ssq, m);
        const float rs = rsqrtf(ssq * (1.f / 1024.f) + EPSF);
#pragma unroll
        for (int i = 0; i < 4; ++i) { const float4 w = *(const float4*)(p.norm_pre + i * 256 + lane * 4);
            x[i * 4 + 0] *= rs * w.x; x[i * 4 + 1] *= rs * w.y; x[i * 4 + 2] *= rs * w.z; x[i * 4 + 3] *= rs * w.w;
            *(uint2*)(xn + (size_t)r * 1024 + i * 256 + lane * 4) = make_uint2(pk2(x[i * 4 + 0], x[i * 4 + 1]), pk2(x[i * 4 + 2], x[i * 4 + 3])); }
    }
}

struct EpiIn {
    static constexpr bool PERM = false, AFTER_DRAIN = false, HAS_MID = false;
    int mode; int dry; const P* pp;
    __device__ __forceinline__ void operator()(const f32x4 (&acc)[2][2][4][2], const Unit& u, int wr, int wc, int fr, int fq) const {
        const int row0 = u.pm * 256 + wr * 64 + fr;
        if (mode == 0 && u.pn == 12) {
            if (wc == 0) { float* betab = (float*)(pp->ws + WS_BETA); float* gb = (float*)(pp->ws + WS_G);
                float4 al = make_float4(0.f, 0.f, 0.f, 0.f), db = al;
                if (fq >= 2) { al = *(const float4*)(pp->a_log + 4 * (fq - 2)); db = *(const float4*)(pp->dt_bias + 4 * (fq - 2)); }
#pragma unroll
                for (int ai = 0; ai < 2; ++ai)
#pragma unroll
                    for (int m = 0; m < 4; ++m) { const int row = row0 + ai * 128 + m * 16; const f32x4 v = acc[ai][0][m][0];
                        if (fq < 2) *(float4*)(betab + (size_t)row * 8 + 4 * fq) = make_float4(sigm(v[0]), sigm(v[1]), sigm(v[2]), sigm(v[3]));
                        else { const float z0 = v[0] + db.x, z1 = v[1] + db.y, z2 = v[2] + db.z, z3 = v[3] + db.w;
                            *(float4*)(gb + (size_t)row * 8 + 4 * (fq - 2)) = make_float4(-__expf(al.x) * (z0 > 20.f ? z0 : __logf(1.f + __expf(z0))), -__expf(al.y) * (z1 > 20.f ? z1 : __logf(1.f + __expf(z1))),
                                                                                       -__expf(al.z) * (z2 > 20.f ? z2 : __logf(1.f + __expf(z2))), -__expf(al.w) * (z3 > 20.f ? z3 : __logf(1.f + __expf(z3)))); } } }
        } else if (mode == 0) {
            bf16_t* qkv = (bf16_t*)(pp->ws + WS_QKV);
#pragma unroll
            for (int ai = 0; ai < 2; ++ai)
#pragma unroll
                for (int m = 0; m < 4; ++m) { const int row = row0 + ai * 128 + m * 16; {
#pragma unroll
                    for (int bj = 0; bj < 2; ++bj) { const int oc = u.pn * 256 + bj * 128 + wc * 32 + 8 * fq; const f32x4 v0 = acc[ai][bj][m][0], v1 = acc[ai][bj][m][1];
                        uint4 o; o.x = pk2(v0[0], v0[1]); o.y = pk2(v0[2], v0[3]); o.z = pk2(v1[0], v1[1]); o.w = pk2(v1[2], v1[3]);
                        *(uint4*)(qkv + (size_t)row * QKVD + oc) = o; } } }
        } else if (mode == 1) {
            if (u.pn >= 20) gates(acc, u.pn - 20, row0, wc, fq);
            else if (u.pn < 4) {
                bf16_t* Z = (bf16_t*)(pp->ws + WS_YA);
#pragma unroll
                for (int ai = 0; ai < 2; ++ai)
#pragma unroll
                    for (int m = 0; m < 4; ++m) { const int row = row0 + ai * 128 + m * 16;
#pragma unroll
                        for (int bj = 0; bj < 2; ++bj) { const int oc = u.pn * 256 + bj * 128 + wc * 32 + 8 * fq; const f32x4 v0 = acc[ai][bj][m][0], v1 = acc[ai][bj][m][1];
                            uint4 o; o.x = pk2(silu(v0[0]), silu(v0[1])); o.y = pk2(silu(v0[2]), silu(v0[3])); o.z = pk2(silu(v1[0]), silu(v1[1])); o.w = pk2(silu(v1[2]), silu(v1[3]));
                            *(uint4*)(Z + (size_t)row * 1024 + oc) = o; } }
            } else {
                const int tile = u.pn - 4; bf16_t* dstb = (tile < 8) ? (bf16_t*)pp->out : (bf16_t*)(pp->ws + WS_MERGED);
                const int ch = 128 * (tile & 7) + 32 * wc + 8 * fq;
#pragma unroll
                for (int ai = 0; ai < 2; ++ai)
#pragma unroll
                    for (int m = 0; m < 4; ++m) { const int row = row0 + ai * 128 + m * 16;
                        const f32x4 x0 = acc[ai][0][m][0], x1 = acc[ai][1][m][0], y0 = acc[ai][0][m][1], y1 = acc[ai][1][m][1];
                        uint4 o;
                        if (tile < 8) { o.x = pk2(x0[0] * y0[0], x0[1] * y0[1]); o.y = pk2(x0[2] * y0[2], x0[3] * y0[3]); o.z = pk2(x1[0] * y1[0], x1[1] * y1[1]); o.w = pk2(x1[2] * y1[2], x1[3] * y1[3]); }
                        else { o.x = pk2(x0[0] * silu(y0[0]), x0[1] * silu(y0[1])); o.y = pk2(x0[2] * silu(y0[2]), x0[3] * silu(y0[3])); o.z = pk2(x1[0] * silu(y1[0]), x1[1] * silu(y1[1])); o.w = pk2(x1[2] * silu(y1[2]), x1[3] * silu(y1[3])); }
                        *(uint4*)(dstb + (size_t)row * 1024 + ch) = o; }
            }
        }
    }
    __device__ __forceinline__ void gates(const f32x4 (&acc)[2][2][4][2], const int pn, const int row0, const int wc, const int fq) const {
        bf16_t* G = (bf16_t*)(pp->ws + (pn < 4 ? WS_GA : WS_GB));
#pragma unroll
        for (int bj = 0; bj < 2; ++bj) { const int oc = 256 * pn + 128 * bj + 32 * wc + 8 * fq;
            const float4 b0 = *(const float4*)(pp->b_gate + oc), b1 = *(const float4*)(pp->b_gate + oc + 4);
#pragma unroll
            for (int ai = 0; ai < 2; ++ai)
#pragma unroll
                for (int m = 0; m < 4; ++m) { const int row = row0 + ai * 128 + m * 16; const f32x4 v0 = acc[ai][bj][m][0], v1 = acc[ai][bj][m][1];
                    uint4 o; o.x = pk2(sigm(v0[0] + b0.x), sigm(v0[1] + b0.y)); o.y = pk2(sigm(v0[2] + b0.z), sigm(v0[3] + b0.w)); o.z = pk2(sigm(v1[0] + b1.x), sigm(v1[1] + b1.y)); o.w = pk2(sigm(v1[2] + b1.z), sigm(v1[3] + b1.w));
                    *(uint4*)(G + (size_t)row * 1024 + (oc & 1023)) = o; } }
    }
};

struct EpiMerge {
    static constexpr bool PERM = false, AFTER_DRAIN = false, HAS_MID = false;
    int pass; const P* pp;
    __device__ __forceinline__ void operator()(const f32x4 (&acc)[2][2][4][2], const Unit& u, int wr, int wc, int fr, int fq) const {
        const bf16_t* G = (const bf16_t*)(pp->ws + (pass ? WS_GB : WS_GA)); bf16_t* Mg = (bf16_t*)(pp->ws + WS_MERGED);
        unsigned* flag = (unsigned*)(pp->ws + WS_BAR) + 3456 + 16 + (u.tag >= 0 ? u.tag : 0);
        const int row0 = u.pm * 256 + wr * 64 + fr, col0 = u.pn * 256 + wc * 32 + 4 * fq;
        if (pass && u.tag >= 0) {
            unsigned spins = 0;
            while ((unsigned)__builtin_amdgcn_readfirstlane(__hip_atomic_load(flag, __ATOMIC_RELAXED, __HIP_MEMORY_SCOPE_AGENT)) < 8u && ++spins < (1u << 22)) __builtin_amdgcn_s_sleep(2);
            __builtin_amdgcn_fence(__ATOMIC_ACQUIRE, "agent");
            asm volatile("s_waitcnt vmcnt(0)" ::: "memory");
        }
#pragma unroll
        for (int ai = 0; ai < 2; ++ai)
#pragma unroll
            for (int m = 0; m < 4; ++m)
#pragma unroll
                for (int bj = 0; bj < 2; ++bj)
#pragma unroll
                    for (int n = 0; n < 2; ++n) { const size_t off = (size_t)(row0 + ai * 128 + m * 16) * 1024 + col0 + bj * 128 + n * 16; const uint2 v = *(const uint2*)(G + off);
                        const f32x4 a = acc[ai][bj][m][n];
                        float r0 = a[0] * bf2f(v.x & 0xffffu), r1 = a[1] * bf2f(v.x >> 16), r2 = a[2] * bf2f(v.y & 0xffffu), r3 = a[3] * bf2f(v.y >> 16);
                        if (pass) { const uint2 o = *(const uint2*)(Mg + off); r0 += bf2f(o.x & 0xffffu); r1 += bf2f(o.x >> 16); r2 += bf2f(o.y & 0xffffu); r3 += bf2f(o.y >> 16); }
                        *(uint2*)(Mg + off) = make_uint2(pk2(r0, r1), pk2(r2, r3)); }
        if (!pass && u.tag >= 0) {
            asm volatile("s_waitcnt vmcnt(0)" ::: "memory");
            __builtin_amdgcn_fence(__ATOMIC_RELEASE, "agent");
            asm volatile("s_waitcnt vmcnt(0)" ::: "memory");
            if (fr == 0 && fq == 0) __hip_atomic_fetch_add(flag, 1u, __ATOMIC_RELAXED, __HIP_MEMORY_SCOPE_AGENT);
        }
    }
};

struct EpiPre {
    static constexpr bool PERM = false, AFTER_DRAIN = false, HAS_MID = false;
    const P* pp;
    __device__ __forceinline__ void operator()(const f32x4 (&acc)[2][2][4][2], const Unit& u, int wr, int wc, int fr, int fq) const {
        const int row0 = u.pm * 256 + wr * 64 + fr, col0 = u.pn * 256 + wc * 32 + 4 * fq;
#pragma unroll
        for (int ai = 0; ai < 2; ++ai)
#pragma unroll
            for (int m = 0; m < 4; ++m) { const int row = row0 + ai * 128 + m * 16; float* dst = nullptr;
                if (row < MPROWS) { const int b = row / TP, t = row - b * TP; if (t >= NMETA) dst = pp->out + O_YP + ((size_t)b * SEQ + (t - NMETA)) * DM; }
                else if (row < MREAL) dst = pp->out + O_YS + (size_t)(row - MPROWS) * DM;
                if (dst) {
#pragma unroll
                    for (int bj = 0; bj < 2; ++bj)
#pragma unroll
                        for (int n = 0; n < 2; ++n) { const f32x4 a = acc[ai][bj][m][n]; *(uint2*)((bf16_t*)dst + col0 + bj * 128 + n * 16) = make_uint2(pk2(a[0], a[1]), pk2(a[2], a[3])); } } }
    }
};


template <int N> __device__ __forceinline__ void tri_merge(const float* Am, float* Tm, float* M1, int tid) {
    constexpr int TOT = (32 / N) * N * N;
    for (int o = tid; o < TOT; o += 512) { const int pr = o / (N * N), i = (o / N) % N, j = o % N, base = pr * 2 * N; float s = 0.f;
#pragma unroll 8
        for (int k = 0; k < N; ++k) s += Am[(base + N + i) * 68 + base + k] * Tm[(base + k) * 68 + base + j];
        M1[(pr * N + i) * 36 + j] = s; }
    __syncthreads();
    for (int o = tid; o < TOT; o += 512) { const int pr = o / (N * N), i = (o / N) % N, j = o % N, base = pr * 2 * N; float s = 0.f;
#pragma unroll 8
        for (int k = 0; k < N; ++k) s += Tm[(base + N + i) * 68 + base + N + k] * M1[(pr * N + k) * 36 + j];
        Tm[(base + N + i) * 68 + base + j] = -s; }
    __syncthreads();
}

__device__ __forceinline__ void phase2(const P& p, unsigned char* smem, const int parts) {
    int tid_2 = threadIdx.x; asm volatile("" : "+v"(tid_2));
    const int tid = tid_2, lane = tid & 63, wid = tid >> 6, fr = lane & 15, fq = lane >> 4;
    float* Gs = (float*)smem; float* Bs = (float*)(smem + 256);
    bf16_t* kS = (bf16_t*)(smem + 512); bf16_t* qS = kS + 64 * 136; bf16_t* vbT = qS + 64 * 136; bf16_t* kbgT = vbT + 128 * 72; bf16_t* kdT = kbgT + 128 * 72;
    float* Am = (float*)(kdT + 128 * 72); float* Tm = Am + 64 * 68; float* M1 = Tm + 64 * 68; bf16_t* Tb = (bf16_t*)(M1 + 32 * 36);
    const bf16_t* qkv = (const bf16_t*)(p.ws + WS_QKV);
    const float* betab = (const float*)(p.ws + WS_BETA); const float* gbuf = (const float*)(p.ws + WS_G);
    float* egb = (float*)(p.ws + WS_EG);
#ifndef P2_PARTS
#define P2_PARTS 3
#endif
    unsigned xr[3][11]; float2 wv[3][4]; float gpre = 0.f, bpre = 0.f;
    auto load_raw = [&](const int cj, const int lane_, const int wid_, const int tid_) __attribute__((always_inline)) {
        const int bh2 = cj / NCPS, c2 = cj - bh2 * NCPS, b2 = bh2 >> 3, h2 = bh2 & 7; const int t02 = c2 == 0 ? 0 : NMETA + 64 * (c2 - 1), L2 = c2 == 0 ? NMETA : 64;
#pragma unroll
        for (int s = 0; s < 3; ++s) { const int col = s * 1024 + h2 * 128 + 2 * lane_;
#pragma unroll
            for (int j = 0; j < 4; ++j) wv[s][j] = *(const float2*)(p.conv_qkv_w + j * QKVD + col);
#pragma unroll
            for (int i = 0; i < 11; ++i) { const int tt = t02 + 8 * wid_ - 3 + i; xr[s][i] = __builtin_nontemporal_load((const unsigned*)(qkv + (size_t)(b2 * TP + (tt >= 0 ? tt : 0)) * QKVD + col)); } }
        if (tid_ < 64) { const int r = b2 * TP + t02 + (tid_ < L2 ? tid_ : 0); gpre = gbuf[(size_t)r * 8 + h2]; bpre = betab[(size_t)r * 8 + h2]; }
    };
    if ((parts & 1) && (int)blockIdx.x < NCHUNK) load_raw(blockIdx.x, lane, wid, tid);
    for (int ci = blockIdx.x; ci < ((parts & 1) ? NCHUNK : 0); ci += gridDim.x) {
        int tid_l = tid_2; asm volatile("" : "+v"(tid_l));
        const int tid = tid_l, lane = tid & 63, wid = tid >> 6, fr = lane & 15, fq = lane >> 4;
        const int bh = ci / NCPS, c = ci - bh * NCPS, b = bh >> 3, h = bh & 7;
        const int t0 = c == 0 ? 0 : NMETA + 64 * (c - 1), L = c == 0 ? NMETA : 64;
        const int rb = b * TP + t0;
        unsigned char* rec = chunk_rec(p, ci);
        if (tid < 64) {
            float gv = (tid < L) ? gpre : 0.f; const float bv = (tid < L) ? bpre : 0.f;
#pragma unroll
            for (int d = 1; d < 64; d <<= 1) { const float o = __shfl_up(gv, d); if (lane >= d) gv += o; }
            Gs[tid] = gv; Bs[tid] = bv;
        }
        for (int i = tid; i < 64 * 68; i += 512) Tm[i] = 0.f;
        __syncthreads();
        for (int rA = 0; rA < 1 + ((BLK_RPT >> 0) & 1) * 4; ++rA) {
            if (rA) __syncthreads();
            const int cp = lane, tb = 8 * wid;
            float eG[8], eD[8], bt[8];
            { const float Gl = Gs[63];
#pragma unroll
              for (int tk = 0; tk < 8; ++tk) { const float Gt = Gs[tb + tk]; eG[tk] = __expf(Gt); eD[tk] = __expf(Gl - Gt); bt[tk] = Bs[tb + tk]; } }
#pragma unroll
            for (int s = 0; s < 3; ++s) {
                float2 w[4];
#pragma unroll
                for (int j = 0; j < 4; ++j) w[j] = wv[s][j];
                float xa[11], xb[11];
#pragma unroll
                for (int i = 0; i < 11; ++i) { const int tt = t0 + tb - 3 + i; const unsigned v = xr[s][i];
                    const float m = tt >= 0 ? 1.f : 0.f; xa[i] = bf2f(v & 0xffffu) * m; xb[i] = bf2f(v >> 16) * m; }
                if (s == 2 && ci + (int)gridDim.x < NCHUNK) load_raw(ci + gridDim.x, lane, wid, tid);
                float ya[8], yb[8], sq[8];
#pragma unroll
                for (int tk = 0; tk < 8; ++tk) { float a = 0.f, c = 0.f;
#pragma unroll
                    for (int j = 0; j < 4; ++j) { a += w[j].x * xa[tk + j]; c += w[j].y * xb[tk + j]; }
                    const bool valid = (tb + tk) < L; ya[tk] = valid ? silu(a) : 0.f; yb[tk] = valid ? silu(c) : 0.f; sq[tk] = ya[tk] * ya[tk] + yb[tk] * yb[tk]; }
                if (s < 2) {
#pragma unroll
                    for (int i = 0; i < 4; ++i) { const bool up = lane & 32; const float keep = up ? sq[i + 4] : sq[i], send = up ? sq[i] : sq[i + 4]; sq[i] = keep + __shfl_xor(send, 32); }
#pragma unroll
                    for (int i = 0; i < 2; ++i) { const bool up = lane & 16; const float keep = up ? sq[i + 2] : sq[i], send = up ? sq[i] : sq[i + 2]; sq[i] = keep + __shfl_xor(send, 16); }
                    { const bool up = lane & 8; const float keep = up ? sq[1] : sq[0], send = up ? sq[0] : sq[1]; sq[0] = keep + __shfl_xor(send, 8); }
                    sq[0] += __shfl_xor(sq[0], 4); sq[0] += __shfl_xor(sq[0], 2); sq[0] += __shfl_xor(sq[0], 1);
                    const float tot = sq[0];
#pragma unroll
                    for (int tk = 0; tk < 8; ++tk) { const float n2 = __shfl(tot, 32 * (tk >> 2) + 16 * ((tk >> 1) & 1) + 8 * (tk & 1));
                        const float rn = rsqrtf(n2 + EPSF) * (s == 0 ? 0.08838834764831845f : 1.f); ya[tk] *= rn; yb[tk] *= rn; }
                }
                if (s == 0) {
#pragma unroll
                    for (int tk = 0; tk < 8; ++tk) { *(unsigned*)(qS + (tb + tk) * 136 + 2 * cp) = pk2(ya[tk], yb[tk]);
                        if (REC_MASK & 1) *(unsigned*)(rec + 16384 + ((tb + tk) * 128 + 2 * cp) * 2) = pk2(ya[tk] * eG[tk], yb[tk] * eG[tk]); }
                } else if (s == 1) {
#pragma unroll
                    for (int tk = 0; tk < 8; ++tk) *(unsigned*)(kS + (tb + tk) * 136 + 2 * cp) = pk2(ya[tk], yb[tk]);
                    uint4 o;
                    o.x = pk2(ya[0] * bt[0] * eG[0], ya[1] * bt[1] * eG[1]); o.y = pk2(ya[2] * bt[2] * eG[2], ya[3] * bt[3] * eG[3]); o.z = pk2(ya[4] * bt[4] * eG[4], ya[5] * bt[5] * eG[5]); o.w = pk2(ya[6] * bt[6] * eG[6], ya[7] * bt[7] * eG[7]);
                    *(uint4*)(kbgT + (2 * cp) * 72 + tb) = o;
                    o.x = pk2(yb[0] * bt[0] * eG[0], yb[1] * bt[1] * eG[1]); o.y = pk2(yb[2] * bt[2] * eG[2], yb[3] * bt[3] * eG[3]); o.z = pk2(yb[4] * bt[4] * eG[4], yb[5] * bt[5] * eG[5]); o.w = pk2(yb[6] * bt[6] * eG[6], yb[7] * bt[7] * eG[7]);
                    *(uint4*)(kbgT + (2 * cp + 1) * 72 + tb) = o;
                    o.x = pk2(ya[0] * eD[0], ya[1] * eD[1]); o.y = pk2(ya[2] * eD[2], ya[3] * eD[3]); o.z = pk2(ya[4] * eD[4], ya[5] * eD[5]); o.w = pk2(ya[6] * eD[6], ya[7] * eD[7]);
                    *(uint4*)(kdT + (2 * cp) * 72 + tb) = o;
                    o.x = pk2(yb[0] * eD[0], yb[1] * eD[1]); o.y = pk2(yb[2] * eD[2], yb[3] * eD[3]); o.z = pk2(yb[4] * eD[4], yb[5] * eD[5]); o.w = pk2(yb[6] * eD[6], yb[7] * eD[7]);
                    *(uint4*)(kdT + (2 * cp + 1) * 72 + tb) = o;
                } else {
                    uint4 o;
                    o.x = pk2(ya[0] * bt[0], ya[1] * bt[1]); o.y = pk2(ya[2] * bt[2], ya[3] * bt[3]); o.z = pk2(ya[4] * bt[4], ya[5] * bt[5]); o.w = pk2(ya[6] * bt[6], ya[7] * bt[7]);
                    *(uint4*)(vbT + (2 * cp) * 72 + tb) = o;
                    o.x = pk2(yb[0] * bt[0], yb[1] * bt[1]); o.y = pk2(yb[2] * bt[2], yb[3] * bt[3]); o.z = pk2(yb[4] * bt[4], yb[5] * bt[5]); o.w = pk2(yb[6] * bt[6], yb[7] * bt[7]);
                    *(uint4*)(vbT + (2 * cp + 1) * 72 + tb) = o;
                }
            }
        }
        __syncthreads();
        {
#pragma unroll
            for (int i = 0; i < 2; ++i) { const int idx = tid * 2 + i, kch = idx >> 3, pc = idx & 7; if (REC_MASK & 2) *(uint4*)(rec + 32768 + (kch * 64 + pc * 8) * 2) = *(const uint4*)(kdT + kch * 72 + pc * 8); }
            if (tid == 0) egb[ci] = __expf(Gs[63]);
        }
        for (int rB = 0; rB < 1 + ((BLK_RPT >> 1) & 1) * 4; ++rB) {
            if (rB) __syncthreads();
            const int mt = wid & 3, sel = wid >> 2; const bf16_t* As = sel ? qS : kS;
            bf16x8 af[4];
#pragma unroll
            for (int kk = 0; kk < 4; ++kk) af[kk] = *(const bf16x8*)(As + (16 * mt + fr) * 136 + 32 * kk + 8 * fq);
#pragma unroll
            for (int nt = 0; nt < 4; ++nt) {
                f32x4 acc = {0.f, 0.f, 0.f, 0.f};
                if (nt <= mt) {
#pragma unroll
                    for (int kk = 0; kk < 4; ++kk) { const bf16x8 bb = *(const bf16x8*)(kS + (16 * nt + fr) * 136 + 32 * kk + 8 * fq); acc = sel ? mfma16(bb, af[kk], acc) : mfma16(af[kk], bb, acc); }
                }
                if (sel == 0) { const int j = 16 * nt + fr; const float Gj = Gs[j];
#pragma unroll
                    for (int jj = 0; jj < 4; ++jj) { const int i = 16 * mt + 4 * fq + jj; const float dec = (i >= j) ? __expf(Gs[i] - Gj) : 0.f; Am[i * 68 + j] = (i > j) ? Bs[i] * acc[jj] * dec : 0.f; }
                } else { const int i = 16 * mt + fr; const float Gi = Gs[i]; float a4[4];
#pragma unroll
                    for (int jj = 0; jj < 4; ++jj) { const int j = 16 * nt + 4 * fq + jj; a4[jj] = (i >= j) ? acc[jj] * __expf(Gi - Gs[j]) : 0.f; }
                    if (REC_MASK & 4) *(uint2*)(rec + 65536 + (i * 64 + 16 * nt + 4 * fq) * 2) = make_uint2(pk2(a4[0], a4[1]), pk2(a4[2], a4[3])); }
            }
        }
        __syncthreads();
        for (int rC = 0; rC < 1 + ((BLK_RPT >> 2) & 1) * 4; ++rC) if (wid == 0) {
            const int blk = lane >> 4, cc = lane & 15; float x[16];
#pragma unroll
            for (int i = 0; i < 16; ++i) { float s = (i == cc) ? 1.f : 0.f;
#pragma unroll
                for (int j = 0; j < i; ++j) s -= Am[(16 * blk + i) * 68 + 16 * blk + j] * x[j];
                x[i] = s; }
#pragma unroll
            for (int i = 0; i < 16; ++i) Tm[(16 * blk + i) * 68 + 16 * blk + cc] = x[i];
        }
        __syncthreads();
        {
            const int base = 32 * (wid & 1), mi = (wid >> 1) & 1, ni = wid & 1;
            if (wid < 2) { f32x4 acc = {0.f, 0.f, 0.f, 0.f};
#pragma unroll
                for (int ks = 0; ks < 4; ++ks) acc = __builtin_amdgcn_mfma_f32_16x16x4f32(Am[(base + 16 + fr) * 68 + base + 4 * ks + fq], Tm[(base + 4 * ks + fq) * 68 + base + fr], acc, 0, 0, 0);
#pragma unroll
                for (int j = 0; j < 4; ++j) M1[(16 * wid + 4 * fq + j) * 36 + fr] = acc[j]; }
            __syncthreads();
            if (wid < 2) { f32x4 acc = {0.f, 0.f, 0.f, 0.f};
#pragma unroll
                for (int ks = 0; ks < 4; ++ks) acc = __builtin_amdgcn_mfma_f32_16x16x4f32(Tm[(base + 16 + fr) * 68 + base + 16 + 4 * ks + fq], M1[(16 * wid + 4 * ks + fq) * 36 + fr], acc, 0, 0, 0);
#pragma unroll
                for (int j = 0; j < 4; ++j) Tm[(base + 16 + 4 * fq + j) * 68 + base + fr] = -acc[j]; }
            __syncthreads();
            if (wid < 4) { f32x4 acc = {0.f, 0.f, 0.f, 0.f};
#pragma unroll
                for (int ks = 0; ks < 8; ++ks) acc = __builtin_amdgcn_mfma_f32_16x16x4f32(Am[(32 + 16 * mi + fr) * 68 + 4 * ks + fq], Tm[(4 * ks + fq) * 68 + 16 * ni + fr], acc, 0, 0, 0);
#pragma unroll
                for (int j = 0; j < 4; ++j) M1[(16 * mi + 4 * fq + j) * 36 + 16 * ni + fr] = acc[j]; }
            __syncthreads();
            if (wid < 4) { f32x4 acc = {0.f, 0.f, 0.f, 0.f};
#pragma unroll
                for (int ks = 0; ks < 8; ++ks) acc = __builtin_amdgcn_mfma_f32_16x16x4f32(Tm[(32 + 16 * mi + fr) * 68 + 32 + 4 * ks + fq], M1[(4 * ks + fq) * 36 + 16 * ni + fr], acc, 0, 0, 0);
#pragma unroll
                for (int j = 0; j < 4; ++j) Tm[(32 + 16 * mi + 4 * fq + j) * 68 + 16 * ni + fr] = -acc[j]; }
            __syncthreads();
        }
        { const int row = tid >> 3, c8 = (tid & 7) * 8; const float4 a = *(const float4*)(Tm + row * 68 + c8), bq = *(const float4*)(Tm + row * 68 + c8 + 4);
            uint4 o; o.x = pk2(a.x, a.y); o.y = pk2(a.z, a.w); o.z = pk2(bq.x, bq.y); o.w = pk2(bq.z, bq.w); *(uint4*)(Tb + row * 72 + c8) = o; }
        __syncthreads();
        if (REC_MASK & 32) { for (int i = tid; i < 64 * 72 / 8; i += 512) *(uint4*)(rec + 49152 + i * 16) = *(const uint4*)(Tb + i * 8); }
        if (REC_MASK & 64) { for (int i = tid; i < 1024; i += 512) *(uint4*)(rec + i * 16) = *(const uint4*)(vbT + i * 8); }
        if (REC_MASK & 128) { for (int i = tid; i < 1024; i += 512) *(uint4*)(rec + i * 16) = *(const uint4*)((const unsigned char*)Am + i * 16); }
        for (int rE = 0; rE < 1 + ((BLK_RPT >> 4) & 1) * 4; ++rE) if (wid < 4) {
            const int mt = wid; bf16x8 af[2];
#pragma unroll
            for (int kk = 0; kk < 2; ++kk) af[kk] = *(const bf16x8*)(Tb + (16 * mt + fr) * 72 + 32 * kk + 8 * fq);
#pragma unroll
            for (int nt = 0; nt < 8; ++nt) { f32x4 acc = {0.f, 0.f, 0.f, 0.f};
#pragma unroll
                for (int kk = 0; kk < 2; ++kk) { const bf16x8 bb = *(const bf16x8*)(vbT + (16 * nt + fr) * 72 + 32 * kk + 8 * fq); acc = mfma16(af[kk], bb, acc); }
                if (REC_MASK & 8) *(uint2*)(rec + 49152 + ((16 * nt + fr) * 64 + 16 * mt + 4 * fq) * 2) = make_uint2(pk2(acc[0], acc[1]), pk2(acc[2], acc[3])); }
        } else {
#pragma unroll
            for (int mi = 0; mi < 2; ++mi) { const int mt = (wid - 4) * 2 + mi; bf16x8 af[2];
#pragma unroll
                for (int kk = 0; kk < 2; ++kk) af[kk] = *(const bf16x8*)(kbgT + (16 * mt + fr) * 72 + 32 * kk + 8 * fq);
#pragma unroll
                for (int nt = 0; nt < 4; ++nt) { f32x4 acc = {0.f, 0.f, 0.f, 0.f};
#pragma unroll
                    for (int kk = 0; kk < 2; ++kk) { const bf16x8 bb = *(const bf16x8*)(Tb + (16 * nt + fr) * 72 + 32 * kk + 8 * fq); acc = mfma16(af[kk], bb, acc); }
                    if (REC_MASK & 16) *(uint2*)(rec + ((16 * nt + fr) * 128 + 16 * mt + 4 * fq) * 2) = make_uint2(pk2(acc[0], acc[1]), pk2(acc[2], acc[3])); } }
        }
        __syncthreads();
    }
    {
        int tid_s = threadIdx.x; asm volatile("" : "+v"(tid_s)); const int tid = tid_s, lane = tid & 63, wid = tid >> 6;
        float* qs = (float*)smem; float* ks = qs + 1024; float* vs = ks + 1024; float* red = vs + 1024; float* red2 = red + 512; float* nrm = red2 + 512;
        bf16_t* osb = (bf16_t*)(p.ws + WS_OS); float* ssq8 = (float*)(p.ws + WS_SSQ);
        const int us = tid >> 8, lt = tid & 255, v = lt & 127, kq = lt >> 7, t2 = lt >> 7, ch = lt & 127;
        for (int pu = blockIdx.x; pu < ((parts & 2) ? DB * NH / 2 : 0); pu += gridDim.x) {
            const int unit = 2 * pu + us, b = unit >> 3, h = unit & 7;
            float s[64]; float g4[4], b4[4];
            {
                const float* sd = p.st_delta + ((size_t)(b * 8 + h) * 128 + kq * 64) * 128 + v;
#pragma unroll
                for (int i = 0; i < 64; ++i) s[i] = __builtin_nontemporal_load(sd + (size_t)i * 128);
#pragma unroll
                for (int tk = 0; tk < 4; ++tk) { g4[tk] = gbuf[(size_t)(MPROWS + b * 4 + tk) * 8 + h]; b4[tk] = betab[(size_t)(MPROWS + b * 4 + tk) * 8 + h]; }
            }
            float yv[2][3];
#pragma unroll
            for (int tt2 = 0; tt2 < 2; ++tt2) { const int t = t2 + 2 * tt2;
#pragma unroll
                for (int sc = 0; sc < 3; ++sc) { const int col = sc * 1024 + h * 128 + ch; float y = 0.f;
#pragma unroll
                    for (int j = 0; j < 4; ++j) { const int tt = t - 3 + j;
                        const float xa = p.st_conv_qkv[((size_t)b * 3 + (tt < 0 ? tt + 3 : 0)) * QKVD + col], xb_ = bf2f(qkv[(size_t)(MPROWS + b * 4 + (tt < 0 ? 0 : tt)) * QKVD + col]);
                        y += p.conv_qkv_w[j * QKVD + col] * (tt < 0 ? xa : xb_); }
                    yv[tt2][sc] = silu(y); } }
#pragma unroll
            for (int tt2 = 0; tt2 < 2; ++tt2)
#pragma unroll
                for (int sc = 0; sc < 2; ++sc) { float q = yv[tt2][sc] * yv[tt2][sc];
#pragma unroll
                    for (int m = 32; m >= 1; m >>= 1) q += __shfl_xor(q, m);
                    if (lane == 0) nrm[((us * 2 + sc) * 4 + (t2 + 2 * tt2)) * 2 + (wid & 1)] = q; }
            __syncthreads();
#pragma unroll
            for (int tt2 = 0; tt2 < 2; ++tt2) { const int t = t2 + 2 * tt2;
                const float nq = nrm[((us * 2 + 0) * 4 + t) * 2] + nrm[((us * 2 + 0) * 4 + t) * 2 + 1], nk = nrm[((us * 2 + 1) * 4 + t) * 2] + nrm[((us * 2 + 1) * 4 + t) * 2 + 1];
                qs[(us * 4 + t) * 128 + ch] = yv[tt2][0] * rsqrtf(nq + EPSF) * 0.08838834764831845f; ks[(us * 4 + t) * 128 + ch] = yv[tt2][1] * rsqrtf(nk + EPSF); vs[(us * 4 + t) * 128 + ch] = yv[tt2][2]; }
            __syncthreads();
#pragma unroll
            for (int tk = 0; tk < 4; ++tk) {
                const int row = MPROWS + b * 4 + tk;
                const float eg = __expf(g4[tk]), bt = b4[tk];
                const float* kr = ks + (us * 4 + tk) * 128 + kq * 64; const float* qr = qs + (us * 4 + tk) * 128 + kq * 64;
                float pa = 0.f;
#pragma unroll
                for (int i = 0; i < 64; ++i) pa += kr[i] * s[i];
                red[(us * 2 + kq) * 128 + v] = pa;
                __syncthreads();
                const float kv = eg * (red[(us * 2) * 128 + v] + red[(us * 2 + 1) * 128 + v]);
                const float vn = bt * (vs[(us * 4 + tk) * 128 + v] - kv);
                float po = 0.f;
#pragma unroll
                for (int i = 0; i < 64; ++i) { s[i] = eg * s[i] + kr[i] * vn; po += qr[i] * s[i]; }
                red2[(us * 2 + kq) * 128 + v] = po;
                __syncthreads();
                if (lt < 128) { const float o = red2[(us * 2) * 128 + v] + red2[(us * 2 + 1) * 128 + v];
                    osb[(size_t)(row - MPROWS) * 1024 + h * 128 + v] = (bf16_t)(pk2(o, 0.f) & 0xffffu);
                    float q = o * o;
#pragma unroll
                    for (int m = 32; m >= 1; m >>= 1) q += __shfl_xor(q, m);
                    if (lane == 0) ssq8[(size_t)row * 64 + h * 8 + (wid & 1)] = q;
                } else if (lt < 134) ssq8[(size_t)row * 64 + h * 8 + 2 + (lt - 128)] = 0.f;
            }
            float* so = p.out + O_DSM + ((size_t)(b * 8 + h) * 128 + kq * 64) * 128 + v;
#pragma unroll
            for (int i = 0; i < 64; ++i) __builtin_nontemporal_store(s[i], so + (size_t)i * 128);
            __syncthreads();
        }
    }
    int tid_c = threadIdx.x; asm volatile("" : "+v"(tid_c));
    for (int idx = blockIdx.x * 512 + tid_c; idx < (NB + DB) * 3 * (QKVD / 8); idx += gridDim.x * 512) {
        const int c8 = idx % (QKVD / 8), rr = (idx / (QKVD / 8)) % 3, bb = idx / (3 * (QKVD / 8));
        const bf16_t* src; float* dst;
        if (bb < NB) { src = qkv + (size_t)(bb * TP + TP - 3 + rr) * QKVD + c8 * 8; dst = p.out + O_CQP + ((size_t)bb * 3 + rr) * QKVD + c8 * 8; }
        else { const int b2 = bb - NB; src = qkv + (size_t)(MPROWS + b2 * 4 + 1 + rr) * QKVD + c8 * 8; dst = p.out + O_CQS + ((size_t)b2 * 3 + rr) * QKVD + c8 * 8; }
        float f[8]; unpack8(*(const uint4*)src, f);
        *(float4*)dst = make_float4(f[0], f[1], f[2], f[3]); *(float4*)(dst + 4) = make_float4(f[4], f[5], f[6], f[7]);
    }
}

struct ScanOps { bf16x8 f[10]; uint2 u2[2]; float eg; };
__device__ __forceinline__ void scan_load(ScanOps& o, const P& p, const int ci, const bool roleA, const int wq, const int vs, const int fr, const int fq) {
    const unsigned char* rec = chunk_rec(p, ci);
    if (roleA) { const int mt = wq;
#pragma unroll
        for (int kk = 0; kk < 4; ++kk) { o.f[kk] = *(const bf16x8*)(rec + ((16 * mt + fr) * 128 + 32 * kk + 8 * fq) * 2); o.f[4 + kk] = *(const bf16x8*)(rec + 16384 + ((16 * mt + fr) * 128 + 32 * kk + 8 * fq) * 2); }
#pragma unroll
        for (int kk = 0; kk < 2; ++kk) o.f[8 + kk] = *(const bf16x8*)(rec + 65536 + ((16 * mt + fr) * 64 + 32 * kk + 8 * fq) * 2);
#pragma unroll
        for (int nt = 0; nt < 2; ++nt) o.u2[nt] = *(const uint2*)(rec + 49152 + ((vs * 32 + 16 * nt + fr) * 64 + 16 * mt + 4 * fq) * 2);
    } else { const int kt0 = 2 * wq;
#pragma unroll
        for (int i = 0; i < 2; ++i)
#pragma unroll
            for (int kk = 0; kk < 2; ++kk) o.f[2 * i + kk] = *(const bf16x8*)(rec + 32768 + ((16 * (kt0 + i) + fr) * 64 + 32 * kk + 8 * fq) * 2);
        o.eg = ((const float*)(p.ws + WS_EG))[ci];
    }
}

__device__ __forceinline__ void phase3(const P& p, unsigned char* smem) {
    int tid_3 = threadIdx.x; asm volatile("" : "+v"(tid_3));
    const int tid = tid_3, lane = tid & 63, wid = tid >> 6, fr = lane & 15, fq = lane >> 4;
    bf16_t* sT = (bf16_t*)smem;
    bf16_t* vnT = sT + 32 * 136;
    bf16_t* Y = (bf16_t*)(p.ws + WS_YB); float* ssq8 = (float*)(p.ws + WS_SSQ);
    const bool roleA = wid < 4; const int wq = wid & 3;
    for (int idx = blockIdx.x * 512 + tid; idx < DB * DS * 128; idx += gridDim.x * 512) { const int r = idx >> 7, c8 = (idx & 127) * 8;
        *(uint4*)(Y + (size_t)(MPROWS + r) * 1024 + c8) = *(const uint4*)((const bf16_t*)(p.ws + WS_OS) + (size_t)r * 1024 + c8); }
    bf16_t* oS = vnT + 32 * 72;
    for (int unit = blockIdx.x; unit < NB * NH * 4; unit += gridDim.x) {
        const int xcd_ = unit & 7, slot_ = unit >> 3; const int bh = xcd_ * 8 + (slot_ >> 2), vs = slot_ & 3, b = bh >> 3, h = bh & 7;
        { int tz = tid; asm volatile("" : "+v"(tz)); for (int i = tz; i < 32 * 136 / 2; i += 512) ((unsigned*)sT)[i] = 0u; }
        f32x4 S[2][2];
#pragma unroll
        for (int i = 0; i < 2; ++i)
#pragma unroll
            for (int nt = 0; nt < 2; ++nt) S[i][nt] = (f32x4){0.f, 0.f, 0.f, 0.f};
        ScanOps ops[4];
#pragma unroll
        for (int c = 0; c < 3; ++c) scan_load(ops[c], p, bh * NCPS + c, roleA, wq, vs, fr, fq);
        __syncthreads();
        auto step = [&](const ScanOps& cur, const int c) __attribute__((always_inline)) {
            const int t0 = c == 0 ? 0 : NMETA + 64 * (c - 1), L = c == 0 ? NMETA : 64; const int rb = b * TP + t0;
            f32x4 Q[2];
            if (roleA) { const int mt = wq;
#pragma unroll
                for (int nt = 0; nt < 2; ++nt) { f32x4 Pv = {0.f, 0.f, 0.f, 0.f}; Q[nt] = (f32x4){0.f, 0.f, 0.f, 0.f};
#pragma unroll
                    for (int kk = 0; kk < 4; ++kk) { const bf16x8 bs = *(const bf16x8*)(sT + (16 * nt + fr) * 136 + 32 * kk + 8 * fq); Pv = mfma16(cur.f[kk], bs, Pv); Q[nt] = mfma16(cur.f[4 + kk], bs, Q[nt]); }
                    const uint2 uu = cur.u2[nt]; const float u0 = bf2f(uu.x & 0xffffu), u1 = bf2f(uu.x >> 16), u2 = bf2f(uu.y & 0xffffu), u3 = bf2f(uu.y >> 16);
                    *(uint2*)(vnT + (16 * nt + fr) * 72 + 16 * mt + 4 * fq) = make_uint2(pk2(u0 - Pv[0], u1 - Pv[1]), pk2(u2 - Pv[2], u3 - Pv[3])); }
            }
            __syncthreads();
            if (roleA) { const int mt = wq;
#pragma unroll
                for (int nt = 0; nt < 2; ++nt) {
#pragma unroll
                    for (int kk = 0; kk < 2; ++kk) { const bf16x8 bv = *(const bf16x8*)(vnT + (16 * nt + fr) * 72 + 32 * kk + 8 * fq); Q[nt] = mfma16(cur.f[8 + kk], bv, Q[nt]); }
#pragma unroll
                    for (int jj = 0; jj < 4; ++jj) oS[(16 * mt + 4 * fq + jj) * 40 + 16 * nt + fr] = (bf16_t)(pk2(Q[nt][jj], 0.f) & 0xffffu); }
            } else { const int kt0 = 2 * wq;
#pragma unroll
                for (int nt = 0; nt < 2; ++nt) { bf16x8 bv[2];
#pragma unroll
                    for (int kk = 0; kk < 2; ++kk) bv[kk] = *(const bf16x8*)(vnT + (16 * nt + fr) * 72 + 32 * kk + 8 * fq);
#pragma unroll
                    for (int i = 0; i < 2; ++i) { S[i][nt] *= cur.eg;
#pragma unroll
                        for (int kk = 0; kk < 2; ++kk) S[i][nt] = mfma16(cur.f[2 * i + kk], bv[kk], S[i][nt]);
                        *(uint2*)(sT + (16 * nt + fr) * 136 + 16 * (kt0 + i) + 4 * fq) = make_uint2(pk2(S[i][nt][0], S[i][nt][1]), pk2(S[i][nt][2], S[i][nt][3])); } }
            }
            __syncthreads();
            if (tid < 256) {
                const int row = tid >> 2, pc = tid & 3; float f[8]; const uint4 v = *(const uint4*)(oS + row * 40 + pc * 8); unpack8(v, f);
                float sq = f[0] * f[0] + f[1] * f[1] + f[2] * f[2] + f[3] * f[3] + f[4] * f[4] + f[5] * f[5] + f[6] * f[6] + f[7] * f[7];
                sq += __shfl_xor(sq, 1); sq += __shfl_xor(sq, 2);
                if (row < L) { *(uint4*)(Y + (size_t)(rb + row) * 1024 + h * 128 + vs * 32 + pc * 8) = v;
                    if (pc == 0) *(float2*)(ssq8 + (size_t)(rb + row) * 64 + h * 8 + vs * 2) = make_float2(sq, 0.f); }
            }
        };
#pragma unroll
        for (int c = 0; c < NCPS; ++c) {
            if (c + 3 < NCPS) scan_load(ops[(c + 3) & 3], p, bh * NCPS + c + 3, roleA, wq, vs, fr, fq);
            step(ops[c & 3], c);
        }
        if (!roleA) { const int kt0 = 2 * wq; float* dp = p.out + O_DP + (size_t)bh * 16384;
#pragma unroll
            for (int i = 0; i < 2; ++i)
#pragma unroll
                for (int nt = 0; nt < 2; ++nt)
#pragma unroll
                    for (int jj = 0; jj < 4; ++jj) dp[(16 * (kt0 + i) + 4 * fq + jj) * 128 + vs * 32 + 16 * nt + fr] = S[i][nt][jj]; }
        __syncthreads();
    }
}

__device__ __forceinline__ void phase_conva(const P& p) {
    const bf16_t* ub = (const bf16_t*)p.out; const bf16_t* bz = (const bf16_t*)(p.ws + WS_MERGED); bf16_t* Y = (bf16_t*)(p.ws + WS_YA);
    for (int idx = blockIdx.x * 512 + threadIdx.x; idx < MREAL * 128; idx += gridDim.x * 512) {
        const int row = idx >> 7, ch = (idx & 127) * 8; int b, t; bool samp;
        if (row < MPROWS) { b = row / TP; t = row - b * TP; samp = false; } else { b = (row - MPROWS) >> 2; t = (row - MPROWS) & 3; samp = true; }
        float u0[8], u1[8], u2[8], zz[8];
        unpack8(*(const uint4*)(ub + (size_t)row * 1024 + ch), u2);
#pragma unroll
        for (int d = 1; d <= 2; ++d) { float* dst = d == 1 ? u1 : u0; const bool inseq = t - d >= 0;
            float f0[8]; unpack8(*(const uint4*)(ub + (size_t)(inseq ? row - d : row) * 1024 + ch), f0);
            const float* s = p.st_conv_a + ((size_t)(samp ? b : 0) * 2 + ((samp && !inseq) ? (2 + t - d) : 0)) * 1024 + ch; const float4 a = *(const float4*)s, c = *(const float4*)(s + 4);
            const float f1[8] = {a.x, a.y, a.z, a.w, c.x, c.y, c.z, c.w};
#pragma unroll
            for (int e = 0; e < 8; ++e) dst[e] = inseq ? f0[e] : (samp ? f1[e] : 0.f); }
        unpack8(ldnt16(bz + (size_t)row * 1024 + ch), zz);
        {
            bf16_t* Yb = (bf16_t*)(p.ws + WS_YB); const float* ssq = (const float*)(p.ws + WS_SSQ); const int head = ch >> 7;
            const float4 s0 = *(const float4*)(ssq + (size_t)row * 64 + head * 8), s1 = *(const float4*)(ssq + (size_t)row * 64 + head * 8 + 4);
            const float rstd = rsqrtf((s0.x + s0.y + s0.z + s0.w + s1.x + s1.y + s1.z + s1.w) * (1.f / 128.f) + EPSF);
            float o8[8], z8[8]; unpack8(ldnt16(Yb + (size_t)row * 1024 + ch), o8); unpack8(ldnt16(Y + (size_t)row * 1024 + ch), z8);
            const float4 g0 = *(const float4*)(p.gnorm_w + (ch & 127)), g1 = *(const float4*)(p.gnorm_w + (ch & 127) + 4);
            uint4 r; r.x = pk2(o8[0] * rstd * g0.x * z8[0], o8[1] * rstd * g0.y * z8[1]); r.y = pk2(o8[2] * rstd * g0.z * z8[2], o8[3] * rstd * g0.w * z8[3]);
            r.z = pk2(o8[4] * rstd * g1.x * z8[4], o8[5] * rstd * g1.y * z8[5]); r.w = pk2(o8[6] * rstd * g1.z * z8[6], o8[7] * rstd * g1.w * z8[7]);
            *(uint4*)(Yb + (size_t)row * 1024 + ch) = r; }
        float y[8];
#pragma unroll
        for (int e = 0; e < 8; ++e) y[e] = zz[e] * (p.conv_a_w[ch + e] * u0[e] + p.conv_a_w[1024 + ch + e] * u1[e] + p.conv_a_w[2048 + ch + e] * u2[e]);
        uint4 o; o.x = pk2(y[0], y[1]); o.y = pk2(y[2], y[3]); o.z = pk2(y[4], y[5]); o.w = pk2(y[6], y[7]);
        *(uint4*)(Y + (size_t)row * 1024 + ch) = o;
        float* cdst = nullptr;
        if (!samp && t >= TP - 2) cdst = p.out + O_CAP + ((size_t)b * 2 + (t - (TP - 2))) * 1024 + ch;
        if (samp && t >= 2) cdst = p.out + O_CAS + ((size_t)b * 2 + (t - 2)) * 1024 + ch;
        if (cdst) { *(float4*)cdst = make_float4(u2[0], u2[1], u2[2], u2[3]); *(float4*)(cdst + 4) = make_float4(u2[4], u2[5], u2[6], u2[7]); }
    }
}

__device__ __forceinline__ void phase_final(const P& p) {
    const int lane = threadIdx.x & 63, wid = threadIdx.x >> 6;
    for (int r = blockIdx.x * 8 + wid; r < NB * SEQ + DB * DS; r += gridDim.x * 8) {
        float* dst; const float* xs;
        if (r < NB * SEQ) { dst = p.out + O_YP + (size_t)r * DM; xs = p.x_prompt + (size_t)r * DM; } else { dst = p.out + O_YS + (size_t)(r - NB * SEQ) * DM; xs = p.x_sample + (size_t)(r - NB * SEQ) * DM; }
        float4 v[4]; float ssq = 0.f;
#pragma unroll
        for (int i = 0; i < 4; ++i) { const uint2 q = ldnt8((const bf16_t*)dst + i * 256 + lane * 4); v[i] = make_float4(bf2f(q.x & 0xffffu), bf2f(q.x >> 16), bf2f(q.y & 0xffffu), bf2f(q.y >> 16)); ssq += v[i].x * v[i].x + v[i].y * v[i].y + v[i].z * v[i].z + v[i].w * v[i].w; }
#pragma unroll
        for (int m = 32; m >= 1; m >>= 1) ssq += __shfl_xor(ssq, m);
        const float rs = rsqrtf(ssq * (1.f / 1024.f) + EPSF);
#pragma unroll
        for (int i = 0; i < 4; ++i) { const float4 w = *(const float4*)(p.norm_post + i * 256 + lane * 4), x_ = *(const float4*)(p.norm_post + i * 256 + lane * 4); const f32x4 xt_ = __builtin_nontemporal_load((const f32x4*)(xs + i * 256 + lane * 4)); const float4 x = make_float4(xt_[0], xt_[1], xt_[2], xt_[3]); (void)x_;
            stnt16f(dst + i * 256 + lane * 4, x.x + v[i].x * rs * w.x, x.y + v[i].y * rs * w.y, x.z + v[i].z * rs * w.z, x.w + v[i].w * rs * w.w); }
    }
}

#ifndef PH_MASK
#define PH_MASK 0x3ff
#endif
#define XB_TMO      128
#define XB_XCNT(j)  (256  + 64 * (j))
#define XB_XSUB(j)  (1280 + 64 * (j))
#define XB_XGEN(j)  (2304 + 64 * (j))
#define XB_TOP      3328
#define XB_TOPGEN   3392
#define XCD_BAR_WORDS 3456
#define XB_SPIN_CAP (1u << 18)
#define LAS __attribute__((address_space(3)))

__device__ __forceinline__ unsigned xb_ld(unsigned* p)              { return __hip_atomic_load(p, __ATOMIC_RELAXED, __HIP_MEMORY_SCOPE_AGENT); }
__device__ __forceinline__ unsigned xb_add(unsigned* p, unsigned v) { return __hip_atomic_fetch_add(p, v, __ATOMIC_RELAXED, __HIP_MEMORY_SCOPE_AGENT); }
__device__ __forceinline__ unsigned xb_xcc_id() { return (unsigned)__builtin_amdgcn_s_getreg((3 << 11) | 20) & 0xFu; }
#define XB_SPIN(cond, bar) do { unsigned _sp = 0; while (cond) { __builtin_amdgcn_s_sleep(1); \
    if ((++_sp & 255u) == 0u) { if (xb_ld(&(bar)[XB_TMO])) break; if (_sp > XB_SPIN_CAP) { atomicAdd(&(bar)[XB_TMO], 1u); break; } } } } while (0)

struct XcdBarrier {
    unsigned* bar; unsigned x;
    volatile LAS unsigned* st;
};

__device__ __forceinline__ XcdBarrier xcd_barrier_post(unsigned* bar, volatile LAS unsigned* st) {
    XcdBarrier b; b.bar = bar; b.x = xb_xcc_id(); b.st = st;
    if (threadIdx.x == 0) (void)xb_add(&bar[XB_XCNT(b.x)], 1u);
    return b;
}
__device__ __forceinline__ void xcd_barrier_complete(unsigned* bar, unsigned x, unsigned& nloc, unsigned& nx) {
    const unsigned G = gridDim.x * gridDim.y * gridDim.z;
    unsigned sum, cnt, mine, sp = 0u;
    for (;;) {
        sum = 0u; cnt = 0u; mine = 0u;
#pragma unroll
        for (unsigned j = 0; j < 16; ++j) { const unsigned c = xb_ld(&bar[XB_XCNT(j)]); sum += c; cnt += (c > 0u) ? 1u : 0u; mine = (j == x) ? c : mine; }
        if (sum == G) break;
        __builtin_amdgcn_s_sleep(1);
        if ((++sp & 255u) == 0u) { if (xb_ld(&bar[XB_TMO])) break; if (sp > XB_SPIN_CAP) { atomicAdd(&bar[XB_TMO], 1u); break; } }
    }
    nloc = mine > 0u ? mine : 1u; nx = cnt > 0u ? cnt : 1u;
}

__device__ __forceinline__ void xcd_barrier(const XcdBarrier& b) {
    asm volatile("s_waitcnt vmcnt(0)" ::: "memory");
    __syncthreads();
    if (threadIdx.x == 0) {
        unsigned* bar = b.bar;
        __builtin_amdgcn_s_waitcnt(0);
        unsigned nloc = b.st[0], nx = b.st[1];
        if (nloc == 0u) { xcd_barrier_complete(bar, b.x, nloc, nx); b.st[0] = nloc; b.st[1] = nx; }
        const unsigned old = xb_add(&bar[XB_XSUB(b.x)], 1u);
        const unsigned gen = old / nloc;
        if (old + 1u == (gen + 1u) * nloc) {
            __builtin_amdgcn_fence(__ATOMIC_RELEASE, "agent");
            asm volatile("s_waitcnt vmcnt(0)" ::: "memory");
            const unsigned og = xb_add(&bar[XB_TOP], 1u);
            const unsigned tg = og / nx;
            if (og + 1u == (tg + 1u) * nx) xb_add(&bar[XB_TOPGEN], 1u);
            else XB_SPIN(xb_ld(&bar[XB_TOPGEN]) == tg, bar);
            __builtin_amdgcn_fence(__ATOMIC_ACQUIRE, "agent");
            xb_add(&bar[XB_XGEN(b.x)], 1u);
            asm volatile("s_waitcnt vmcnt(0)" ::: "memory");
        } else {
            XB_SPIN(xb_ld(&bar[XB_XGEN(b.x)]) == gen, bar);
            __builtin_amdgcn_fence(__ATOMIC_ACQUIRE, "agent");
            asm volatile("s_waitcnt vmcnt(0)" ::: "memory");
        }
    }
    __syncthreads();
}


__global__ __launch_bounds__(512, 2) void hybrid_fwd(P p_arg) {
    extern __shared__ __attribute__((aligned(16))) unsigned char smem[];
    const P& p = *(const P*)(const __attribute__((address_space(4))) P*)__builtin_amdgcn_kernarg_segment_ptr();
    PG8_LAS unsigned char* lds = (PG8_LAS unsigned char*)smem;
    unsigned* bar = (unsigned*)(p.ws + WS_BAR);
    volatile LAS unsigned* xbst = (volatile LAS unsigned*)(lds + 139264);
    if (threadIdx.x == 0) { xbst[0] = 0u; xbst[1] = 0u; }
    __syncthreads();
    const XcdBarrier xb = xcd_barrier_post(bar, xbst);
    const bf16_t* xn = (const bf16_t*)(p.ws + WS_XN); const bf16_t* wtin = (const bf16_t*)(p.ws + WS_WTIN);
#if (PH_MASK >> 0) & 1
    for (int rpt_ = 0; rpt_ < 1 + ((RPT_MASK >> 0) & 1); ++rpt_) {
    phase0(p, smem);
    }
#endif
    xcd_barrier(xb);
#if (PH_MASK >> 1) & 1
    for (int rpt_ = 0; rpt_ < 1 + ((RPT_MASK >> 1) & 1); ++rpt_) {
    { StaticOrder S; S.init(MPAD, 3328, (int)gridDim.x, (int)blockIdx.x); EpiIn E; E.dry = 0; E.mode = 0; E.pp = &p; pg8::gemm_phase<EpiIn, StaticOrder, false>(lds, Gemm{xn, wtin, MPAD, 3328, 1024}, S, E, nullptr); }
    }
#endif
    xcd_barrier(xb);
#if (PH_MASK >> 2) & 1
    for (int rpt_ = 0; rpt_ < 1 + ((RPT_MASK >> 2) & 1); ++rpt_) {
    phase2(p, smem, rpt_ == 0 ? 3 : RPT_P2);
    }
#endif
#ifdef DBG_DUMP
    { const uint4* src = (const uint4*)(p.ws + WS_QKV); uint4* dst = (uint4*)p.out; for (size_t i = (size_t)blockIdx.x * 512 + threadIdx.x; i < (size_t)6000000; i += (size_t)gridDim.x * 512) dst[i] = src[i];
      const uint4* s2 = (const uint4*)(p.ws + WS_BETA); for (size_t i = (size_t)blockIdx.x * 512 + threadIdx.x; i < (size_t)68000; i += (size_t)gridDim.x * 512) dst[6000000 + i] = s2[i]; }
#endif
    xcd_barrier(xb);
#if (PH_MASK >> 3) & 1
    for (int rpt_ = 0; rpt_ < 1 + ((RPT_MASK >> 3) & 1); ++rpt_) {
    phase3(p, smem);
    }
#endif
    xcd_barrier(xb);
#if (PH_MASK >> 4) & 1
    for (int rpt_ = 0; rpt_ < 1 + ((RPT_MASK >> 4) & 1); ++rpt_) {
    { StaticOrder S; S.init(MPAD, 7168, (int)gridDim.x, (int)blockIdx.x); EpiIn E; E.dry = (rpt_ == 0 && ((RPT_MASK >> 4) & 1)) ? 1 : 0; E.mode = 1; E.pp = &p; pg8::gemm_phase<EpiIn, StaticOrder, false>(lds, Gemm{xn, wtin + (size_t)3328 * 1024, MPAD, 7168, 1024}, S, E, nullptr); }
    }
#endif
    xcd_barrier(xb);
#if (PH_MASK >> 5) & 1
    for (int rpt_ = 0; rpt_ < 1 + ((RPT_MASK >> 5) & 1); ++rpt_) {
    phase_conva(p);
    }
#endif
    xcd_barrier(xb);
#if (PH_MASK >> 7) & 1
    for (int rpt_ = 0; rpt_ < 1 + ((RPT_MASK >> 7) & 1); ++rpt_) {
    { MergeOrder S; S.init(MPAD, 1024, (int)gridDim.x, (int)blockIdx.x); S.pass = 0; EpiMerge E; E.pp = &p; E.pass = 0; pg8::gemm_phase<EpiMerge, MergeOrder, false>(lds, Gemm{(const bf16_t*)(p.ws + WS_YA), (const bf16_t*)(p.ws + WS_WTA), MPAD, 1024, 1024}, S, E, nullptr);
      S.pass = 1; E.pass = 1; pg8::gemm_phase<EpiMerge, MergeOrder, false>(lds, Gemm{(const bf16_t*)(p.ws + WS_YB), (const bf16_t*)(p.ws + WS_WTB), MPAD, 1024, 1024}, S, E, nullptr); }
    }
#endif
    xcd_barrier(xb);
#if (PH_MASK >> 8) & 1
    for (int rpt_ = 0; rpt_ < 1 + ((RPT_MASK >> 8) & 1); ++rpt_) {
    { StaticOrder S; S.init(MPAD, 1024, (int)gridDim.x, (int)blockIdx.x); EpiPre E; E.pp = &p; pg8::gemm_phase<EpiPre, StaticOrder, false>(lds, Gemm{(const bf16_t*)(p.ws + WS_MERGED), (const bf16_t*)(p.ws + WS_WTO), MPAD, 1024, 1024}, S, E, nullptr); }
    }
#endif
    xcd_barrier(xb);
#if (PH_MASK >> 9) & 1
    for (int rpt_ = 0; rpt_ < 1 + ((RPT_MASK >> 9) & 1); ++rpt_) {
    phase_final(p);
    }
#endif
#ifdef XBAR
    for (unsigned k = 0; k < XBAR; ++k) xcd_barrier(xb);
#endif
}

extern "C" void kernel_launch(void* const* d_in, const int* in_sizes, int n_in, void* d_out, int out_size, void* d_ws, size_t ws_size, hipStream_t stream) {
    static int grid_blocks = 0;
    if (!grid_blocks) {
        int dev = 0, cus = 0, per_cu = 0;
        hipGetDevice(&dev);
        hipDeviceGetAttribute(&cus, hipDeviceAttributeMultiprocessorCount, dev);
        hipFuncSetAttribute((const void*)hybrid_fwd, hipFuncAttributeMaxDynamicSharedMemorySize, LDS_BYTES);
        hipOccupancyMaxActiveBlocksPerMultiprocessor(&per_cu, (const void*)hybrid_fwd, 512, LDS_BYTES);
        if (per_cu < 1) per_cu = 1;
        grid_blocks = cus * per_cu;
        if (ws_size < (size_t)268435456) fprintf(stderr, "kernel_launch: workspace %zu smaller than the 256 MiB this kernel maps\n", ws_size);
    }
    P p{};
    const float* const* in = (const float* const*)d_in;
    p.x_prompt = in[0]; p.x_sample = in[1]; p.st_conv_a = in[2]; p.st_conv_qkv = in[3]; p.st_delta = in[4]; p.meta = in[5]; p.norm_pre = in[6]; p.norm_post = in[7];
    p.w_in = in[8]; p.b_gate = in[9]; p.conv_a_w = in[10]; p.conv_qkv_w = in[11]; p.a_log = in[12]; p.dt_bias = in[13]; p.gnorm_w = in[14]; p.w_a_out = in[15]; p.w_b_out = in[16]; p.w_o = in[17];
    p.out = (float*)d_out; p.ws = (unsigned char*)d_ws;
    hipMemsetAsync((char*)d_ws + WS_BAR, 0, XCD_BAR_WORDS * 4 + 256, stream);
    void* args[] = {&p};
    hipError_t e = hipLaunchCooperativeKernel((const void*)hybrid_fwd, dim3(grid_blocks), dim3(512), args, LDS_BYTES, stream);
    if (e != hipSuccess) fprintf(stderr, "cooperative launch failed: %s (grid %d)\n", hipGetErrorString(e), grid_blocks);
}
```
